# Optimizing an MI355X kernel written in HIP

```python
import math
import jax, jax.numpy as jnp
from jax import lax
import numpy as np

D_MODEL = 2048
BATCH = 8
SEQ = 2048
DEPTH = 1

N_META = 16
ATTN_WIDTH = D_MODEL // 2
CONV_WIDTH = D_MODEL - ATTN_WIDTH
N_ATTN_HEADS = 8
V_HEAD_DIM = ATTN_WIDTH // N_ATTN_HEADS
QK_HEAD_DIM = V_HEAD_DIM // 2
N_CONV_GROUPS = 8
CONV_K = 3
QK_WIDTH = N_ATTN_HEADS * 2 * QK_HEAD_DIM
IN_WIDTH = 2 * QK_WIDTH + ATTN_WIDTH + 3 * CONV_WIDTH
D_FF = int(math.ceil(8 * D_MODEL / 3 / 256) * 256)
Q_BLOCK = 128
NORM_EPS = 1e-6
HEAD_NORM_EPS = 1e-5

kernel_name = "hymba_diffattn_shortconv_swiglu"


def rmsnorm(x, g, eps=NORM_EPS):
    xf = x.astype(jnp.float32)
    y = xf * lax.rsqrt(jnp.mean(xf * xf, axis=-1, keepdims=True) + eps)
    return (y * g.astype(jnp.float32)).astype(x.dtype)


def alibi_slopes(n_heads):
    return jnp.asarray(2.0 ** (-8.0 * (np.arange(n_heads) + 1) / n_heads), dtype=jnp.float32)


def diff_attention(q, k, v, lam, head_g, lambda_init):
    b, t, h, _, dk = q.shape
    dv = v.shape[-1]
    n_blk = t // Q_BLOCK
    scale = 1.0 / math.sqrt(dk)
    slopes = alibi_slopes(h)
    kf = k.astype(jnp.float32)
    vf = v.astype(jnp.float32)
    kpos = jnp.arange(t)
    lam = lam.astype(jnp.float32)

    def block(i):
        start = i * Q_BLOCK
        qb = lax.dynamic_slice_in_dim(q, start, Q_BLOCK, axis=1).astype(jnp.float32)
        s = jnp.einsum('bqhmd,bkhmd->bhmqk', qb, kf) * scale
        qpos = start + jnp.arange(Q_BLOCK)
        dist = (qpos[:, None] - kpos[None, :]).astype(jnp.float32)
        bias = jnp.where(dist >= 0, -slopes[:, None, None] * dist, -jnp.inf)
        p = jax.nn.softmax(s + bias[None, :, None], axis=-1)
        w = p[:, :, 0] - lam * p[:, :, 1]
        return jnp.einsum('bhqk,bkhd->bqhd', w, vf)

    o = lax.map(block, jnp.arange(n_blk))
    o = jnp.transpose(o, (1, 0, 2, 3, 4)).reshape(b, t, h, dv)
    o = o * lax.rsqrt(jnp.mean(o * o, axis=-1, keepdims=True) + HEAD_NORM_EPS)
    o = o * head_g.astype(jnp.float32) * (1.0 - lambda_init)
    return o.reshape(b, t, h * dv).astype(v.dtype)


def short_gated_conv(bg, cg, hin, conv_w):
    u = cg * hin
    t = u.shape[1]
    up = jnp.pad(u, ((0, 0), (CONV_K - 1, 0), (0, 0)))
    y = sum(up[:, j:j + t, :] * conv_w[j] for j in range(CONV_K))
    return bg * y


def setup_inputs(seed: int = 0) -> dict:
    key = jax.random.key(seed)
    ks = jax.random.split(key, 16)
    f32 = jnp.float32
    L, D = DEPTH, D_MODEL
    x = jax.random.normal(ks[0], (BATCH, SEQ, D), f32)
    meta = jax.random.normal(ks[1], (N_META, D), f32)
    norm1_g = 1.0 + 0.02 * jax.random.normal(ks[2], (L, D), f32)
    w_in = jax.random.normal(ks[3], (L, D, IN_WIDTH), f32) * D ** -0.5
    lambda_q1 = 0.1 * jax.random.normal(ks[4], (L, QK_HEAD_DIM), f32)
    lambda_k1 = 0.1 * jax.random.normal(ks[5], (L, QK_HEAD_DIM), f32)
    lambda_q2 = 0.1 * jax.random.normal(ks[6], (L, QK_HEAD_DIM), f32)
    lambda_k2 = 0.1 * jax.random.normal(ks[7], (L, QK_HEAD_DIM), f32)
    head_g = 1.0 + 0.02 * jax.random.normal(ks[8], (L, V_HEAD_DIM), f32)
    conv_w = jax.random.normal(ks[9], (L, CONV_K, CONV_WIDTH), f32) * CONV_K ** -0.5
    w_out = jax.random.normal(ks[10], (L, D, D), f32) * D ** -0.5
    norm2_g = 1.0 + 0.02 * jax.random.normal(ks[11], (L, D), f32)
    w_gate = jax.random.normal(ks[12], (L, D, D_FF), f32) * D ** -0.5
    w_up = jax.random.normal(ks[13], (L, D, D_FF), f32) * D ** -0.5
    w_down = jax.random.normal(ks[14], (L, D_FF, D), f32) * D_FF ** -0.5
    norm_f_g = 1.0 + 0.02 * jax.random.normal(ks[15], (D,), f32)
    return {"x": x, "meta": meta, "norm1_g": norm1_g, "w_in": w_in,
            "lambda_q1": lambda_q1, "lambda_k1": lambda_k1,
            "lambda_q2": lambda_q2, "lambda_k2": lambda_k2,
            "head_g": head_g, "conv_w": conv_w, "w_out": w_out,
            "norm2_g": norm2_g, "w_gate": w_gate, "w_up": w_up,
            "w_down": w_down, "norm_f_g": norm_f_g}


def reference(x, meta, norm1_g, w_in, lambda_q1, lambda_k1, lambda_q2, lambda_k2,
              head_g, conv_w, w_out, norm2_g, w_gate, w_up, w_down, norm_f_g):
    b, s, d = x.shape
    t = s + N_META
    t_pad = ((t + Q_BLOCK - 1) // Q_BLOCK) * Q_BLOCK
    h = jnp.concatenate([jnp.broadcast_to(meta[None].astype(x.dtype), (b, N_META, d)), x], axis=1)
    h = jnp.pad(h, ((0, 0), (0, t_pad - t), (0, 0)))
    splits = np.cumsum([QK_WIDTH, QK_WIDTH, ATTN_WIDTH, CONV_WIDTH, CONV_WIDTH]).tolist()

    for l in range(DEPTH):
        lambda_init = 0.8 - 0.6 * math.exp(-0.3 * l)
        a = rmsnorm(h, norm1_g[l])
        proj = a @ w_in[l]
        q, k, v, bg, cg, hin = jnp.split(proj, splits, axis=-1)
        q = q.reshape(b, t_pad, N_ATTN_HEADS, 2, QK_HEAD_DIM)
        k = k.reshape(b, t_pad, N_ATTN_HEADS, 2, QK_HEAD_DIM)
        v = v.reshape(b, t_pad, N_ATTN_HEADS, V_HEAD_DIM)
        lam = (jnp.exp(jnp.sum(lambda_q1[l].astype(jnp.float32) * lambda_k1[l].astype(jnp.float32)))
               - jnp.exp(jnp.sum(lambda_q2[l].astype(jnp.float32) * lambda_k2[l].astype(jnp.float32)))
               + lambda_init)
        attn_out = diff_attention(q, k, v, lam, head_g[l], lambda_init)
        conv_out = short_gated_conv(bg, cg, hin, conv_w[l])
        h = h + jnp.concatenate([attn_out, conv_out], axis=-1) @ w_out[l]
        f = rmsnorm(h, norm2_g[l])
        h = h + (jax.nn.silu(f @ w_gate[l]) * (f @ w_up[l])) @ w_down[l]

    out = rmsnorm(h, norm_f_g)
    return out[:, N_META:N_META + s, :]
```

```cpp
#include <hip/hip_runtime.h>
#include <hip/hip_cooperative_groups.h>
#include <cstdio>
#include <cstdint>
#include <cmath>
namespace pg8 {
#define PG8_LAS __attribute__((address_space(3)))
typedef unsigned short bf16_t;
typedef short bf16x8 __attribute__((ext_vector_type(8)));
typedef float f32x4 __attribute__((ext_vector_type(4)));
typedef unsigned u32x4 __attribute__((ext_vector_type(4)));
constexpr int BM = 256, BK = 64, HALF = 128, HTB = HALF * BK * 2  , STAGE_BYTES = 8 * HTB, NXCD = 8, WGM = 8;

__host__ __device__ __forceinline__ int lds_byte(int r, int c) { const int st = (r >> 4) * 2 + (c >> 5), rr = r & 15, cc = c & 31, ob = rr * 64 + cc * 2; return st * 1024 + (ob ^ (((ob >> 9) & 1) << 5)); }
__host__ __device__ __forceinline__ void stage_rc(int b, int& R, int& C) { const int st = b / 1024, sb = b % 1024, swz = sb ^ (((sb >> 9) & 1) << 5); R = (st >> 1) * 16 + swz / 64; C = (st & 1) * 32 + (swz % 64) / 2; }
__host__ __device__ __forceinline__ int perm32(int rho) { const int n = rho >> 4, i = rho & 15; return 8 * (i >> 2) + 4 * n + (i & 3); }

struct Unit { int pm, pn; };
struct Gemm { const bf16_t* A; const bf16_t* Bt; int M, N, K; };

struct StaticOrder {
    int nM, nN, nwg, G, c;
    __host__ __device__ void init(int M, int N, int G_, int c_) { nM = M / BM; nN = N / BM; nwg = nM * nN; G = G_; c = c_; }
    __host__ __device__ bool next(int i, Unit& u) const {
        const long L = (long)i * G + c; if (L >= nwg) return false;
        int wgid = (int)L; { const int q = nwg / NXCD, r = nwg % NXCD, xcd = wgid % NXCD, off = wgid / NXCD; wgid = (xcd < r ? xcd * (q + 1) : r * (q + 1) + (xcd - r) * q) + off; }
        const int nig = WGM * nN, gid = wgid / nig, fm = gid * WGM, gsz = (nM - fm) < WGM ? (nM - fm) : WGM;
        u.pm = fm + ((wgid % nig) % gsz); u.pn = (wgid % nig) / gsz; return true;
    }
    __device__ __forceinline__ void a_ready(const Unit&) const {}
    __device__ __forceinline__ void done(const Unit&) const {}
};

__device__ __forceinline__ unsigned cvt_pk_bf16(float lo, float hi) { unsigned r; asm volatile("v_cvt_pk_bf16_f32 %0, %1, %2" : "=v"(r) : "v"(lo), "v"(hi)); return r; }
typedef float f32x2 __attribute__((ext_vector_type(2)));
struct EpiProj {
    static constexpr bool PERM = true, AFTER_DRAIN = false;
    bf16_t* O; float qscale;
    __device__ __forceinline__ void operator()(const f32x4 (&acc)[2][2][4][2], const Unit& u, int wr, int wc, int fr, int fq) const {
        const int row0 = u.pm * BM + wr * 64 + fr; const int colt = u.pn * BM;
        const float sc = (colt < 1024) ? qscale : 1.f;
        const int col0 = colt + wc * 32 + 8 * fq;
#pragma unroll
        for (int ai = 0; ai < 2; ++ai)
#pragma unroll
            for (int m = 0; m < 4; ++m) { bf16_t* rowp = O + (size_t)(row0 + ai * HALF + m * 16) * 6144 + col0;
#pragma unroll
                for (int bj = 0; bj < 2; ++bj) { const f32x4 v0 = acc[ai][bj][m][0] * sc, v1 = acc[ai][bj][m][1] * sc;
                    u32x4 w; w.x = cvt_pk_bf16(v0[0], v0[1]); w.y = cvt_pk_bf16(v0[2], v0[3]); w.z = cvt_pk_bf16(v1[0], v1[1]); w.w = cvt_pk_bf16(v1[2], v1[3]);
                    *(u32x4*)(rowp + bj * HALF) = w; } }
    }
};
template <bool WB> struct EpiRes {
    static constexpr bool PERM = true, AFTER_DRAIN = false;
    const float* X; float* H; bf16_t* Hb; float* ssq;
    __device__ __forceinline__ void operator()(const f32x4 (&acc)[2][2][4][2], const Unit& u, int wr, int wc, int fr, int fq) const {
        const int row0 = u.pm * BM + wr * 64 + fr; const int col0 = u.pn * BM + wc * 32 + 8 * fq;
#pragma unroll
        for (int ai = 0; ai < 2; ++ai)
#pragma unroll
            for (int m = 0; m < 4; ++m) { const int row = row0 + ai * HALF + m * 16; float ss = 0.f;
#pragma unroll
                for (int bj = 0; bj < 2; ++bj) { const size_t off = (size_t)row * 2048 + col0 + bj * HALF;
                    const f32x4 x0 = *(const f32x4*)(X + off), x1 = *(const f32x4*)(X + off + 4);
                    const f32x4 v0 = acc[ai][bj][m][0] + x0, v1 = acc[ai][bj][m][1] + x1;
                    *(f32x4*)(H + off) = v0; *(f32x4*)(H + off + 4) = v1;
                    if (WB) { u32x4 w; w.x = cvt_pk_bf16(v0[0], v0[1]); w.y = cvt_pk_bf16(v0[2], v0[3]); w.z = cvt_pk_bf16(v1[0], v1[1]); w.w = cvt_pk_bf16(v1[2], v1[3]); *(u32x4*)(Hb + off) = w; }
                    ss += (v0[0] * v0[0] + v0[1] * v0[1]) + (v0[2] * v0[2] + v0[3] * v0[3]) + (v1[0] * v1[0] + v1[1] * v1[1]) + (v1[2] * v1[2] + v1[3] * v1[3]); }
                ss += __shfl_xor(ss, 16); ss += __shfl_xor(ss, 32);
                if (fq == 0) atomicAdd(ssq + row, ss); }
    }
};
struct EpiGU {
    static constexpr bool PERM = true, AFTER_DRAIN = false;
    bf16_t* O; const float* ssq;
    __device__ __forceinline__ void operator()(const f32x4 (&acc)[2][2][4][2], const Unit& u, int wr, int wc, int fr, int fq) const {
        const int row0 = u.pm * BM + wr * 64 + fr; const int col0 = u.pn * HALF + wc * 32 + 8 * fq;
#pragma unroll
        for (int ai = 0; ai < 2; ++ai)
#pragma unroll
            for (int m = 0; m < 4; ++m) { const int row = row0 + ai * HALF + m * 16;
                const float rs = __builtin_amdgcn_rsqf(ssq[row] * (1.0f / 2048.0f) + 1e-6f);
                float a[8];
#pragma unroll
                for (int n = 0; n < 2; ++n)
#pragma unroll
                    for (int e = 0; e < 4; ++e) { const float g = acc[ai][0][m][n][e] * rs, up = acc[ai][1][m][n][e] * rs;
                        a[n * 4 + e] = g * __builtin_amdgcn_rcpf(1.0f + __builtin_amdgcn_exp2f(-1.4426950408889634f * g)) * up; }
                u32x4 w; w.x = cvt_pk_bf16(a[0], a[1]); w.y = cvt_pk_bf16(a[2], a[3]); w.z = cvt_pk_bf16(a[4], a[5]); w.w = cvt_pk_bf16(a[6], a[7]);
                *(u32x4*)(O + (size_t)row * 5632 + col0) = w; }
    }
};
template <class Epi, class Sched, bool ALIGN_EPI = false, bool SP2 = false>
__device__ __forceinline__ void gemm_phase(PG8_LAS unsigned char* lds, const Gemm g, const Sched& S, const Epi& E) {
    const int tid = threadIdx.x, wid = __builtin_amdgcn_readfirstlane(tid >> 6), lane = tid & 63, wr = wid >> 2, wc = wid & 3, fr = lane & 15, fq = lane >> 4;
    const int K = g.K, nt = K / BK;
    unsigned voffA[2], voffB[2];
#pragma unroll
    for (int i = 0; i < 2; ++i) { int R, C; stage_rc(tid * 16 + i * 8192, R, C); const int Rb = Epi::PERM ? ((R & ~31) + perm32(R & 31)) : R;
        voffA[i] = (unsigned)(R * K + C) * 2u; voffB[i] = (unsigned)(Rb * K + C) * 2u; }
    const size_t kstep = (size_t)(BK * 2);
    const size_t hstep = (size_t)HALF * K * 2;
    const size_t tstep = 2 * hstep;
    const unsigned ldsw = (unsigned)wid * 1024u;
    const int aoff = lds_byte(wr * 64 + fr, fq * 8), boff = lds_byte(wc * 32 + fr, fq * 8);
#define PG8_SA(b, h) (((b) * 2 + (h)) * HTB)
#define PG8_SB(b, h) ((4 + (b) * 2 + (h)) * HTB)
#define PG8_STAGE(bufoff, gbase, voff) do { _Pragma("unroll") for (int _i = 0; _i < 2; ++_i) \
        __builtin_amdgcn_global_load_lds((const unsigned*)((const char*)(gbase) + (voff)[_i]), (PG8_LAS unsigned*)(lds + (bufoff) + ldsw + _i * 8192), 16, 0, 0); } while (0)
#define PG8_LDA(dst, b, h) do { _Pragma("unroll") for (int m = 0; m < 4; ++m) _Pragma("unroll") for (int k = 0; k < 2; ++k) dst[m][k] = *(const PG8_LAS bf16x8*)(lds + PG8_SA(b, h) + aoff + m * 2048 + k * 1024); } while (0)
#define PG8_LDB(dst, b, h) do { _Pragma("unroll") for (int n = 0; n < 2; ++n) _Pragma("unroll") for (int k = 0; k < 2; ++k) dst[n][k] = *(const PG8_LAS bf16x8*)(lds + PG8_SB(b, h) + boff + n * 2048 + k * 1024); } while (0)
#define PG8_MMA(ai, bj, At, Bt) do { __builtin_amdgcn_s_setprio(1); _Pragma("unroll") for (int m = 0; m < 4; ++m) _Pragma("unroll") for (int n = 0; n < 2; ++n) _Pragma("unroll") for (int k = 0; k < 2; ++k) \
        acc[ai][bj][m][n] = __builtin_amdgcn_mfma_f32_16x16x32_bf16(Bt[n][k], At[m][k], acc[ai][bj][m][n], 0, 0, 0); __builtin_amdgcn_s_setprio(0); } while (0)
#define PG8_WAIT_V(n) asm volatile("s_waitcnt vmcnt(" #n ")" ::: "memory")
#define PG8_WAIT_L(n) asm volatile("s_waitcnt lgkmcnt(" #n ")" ::: "memory")
#define PG8_BAR __builtin_amdgcn_s_barrier()
#define PG8_SCHED __builtin_amdgcn_sched_barrier(0)
    Unit cur, nxt; int ui = 0;
    if (!S.next(0, cur)) return;
    f32x4 acc[2][2][4][2];
#pragma unroll
    for (int a = 0; a < 2; ++a)
#pragma unroll
        for (int b = 0; b < 2; ++b)
#pragma unroll
            for (int m = 0; m < 4; ++m)
#pragma unroll
                for (int n = 0; n < 2; ++n) acc[a][b][m][n] = (f32x4){0.f, 0.f, 0.f, 0.f};
    bf16x8 At[4][2], B0[2][2], B1[2][2];
    const char* cA = (const char*)g.A + (size_t)cur.pm * tstep; const char* cB = (const char*)g.Bt + (size_t)cur.pn * tstep;
    S.a_ready(cur);
    if constexpr (SP2) {
        PG8_STAGE(PG8_SB(0, 0), cB, voffB); PG8_STAGE(PG8_SB(0, 1), cB + hstep, voffB); PG8_STAGE(PG8_SA(0, 0), cA, voffA); PG8_STAGE(PG8_SA(0, 1), cA + hstep, voffA);
        if (wr == 1) PG8_BAR;
        PG8_WAIT_V(2); PG8_BAR;
        PG8_STAGE(PG8_SB(1, 0), cB + kstep, voffB); PG8_STAGE(PG8_SA(1, 0), cA + kstep, voffA); PG8_STAGE(PG8_SB(1, 1), cB + hstep + kstep, voffB);
        PG8_WAIT_V(6); PG8_BAR;
    } else {
        PG8_STAGE(PG8_SB(0, 0), cB, voffB); PG8_STAGE(PG8_SA(0, 0), cA, voffA); PG8_STAGE(PG8_SB(0, 1), cB + hstep, voffB); PG8_STAGE(PG8_SA(0, 1), cA + hstep, voffA);
        if (wr == 1) PG8_BAR;
        PG8_WAIT_V(4); PG8_BAR;
        PG8_STAGE(PG8_SB(1, 0), cB + kstep, voffB); PG8_STAGE(PG8_SA(1, 0), cA + kstep, voffA); PG8_STAGE(PG8_SB(1, 1), cB + hstep + kstep, voffB);
        PG8_WAIT_V(6); PG8_BAR;
    }
    for (;;) {
        const bool has_next = S.next(ui + 1, nxt);
        const char* nA = has_next ? (const char*)g.A + (size_t)nxt.pm * tstep : cA; const char* nB = has_next ? (const char*)g.Bt + (size_t)nxt.pn * tstep : cB;
        for (int t = 0; t < nt; t += 2) {
            const bool last = (t == nt - 2);
            const char* a1 = cA + (size_t)(t + 1) * kstep;
            const char* a2 = last ? nA : cA + (size_t)(t + 2) * kstep; const char* b2 = last ? nB : cB + (size_t)(t + 2) * kstep;
            const char* a3 = a2 + kstep; const char* b3 = b2 + kstep;
            if (last && has_next) S.a_ready(nxt);
            if constexpr (SP2) {
            PG8_LDB(B0, 0, 0); PG8_LDB(B1, 0, 1); PG8_SCHED; PG8_LDA(At, 0, 0); PG8_STAGE(PG8_SA(1, 1), a1 + hstep, voffA);
            PG8_WAIT_V(8); PG8_WAIT_L(0); PG8_BAR; PG8_MMA(0, 0, At, B0); PG8_MMA(0, 1, At, B1); PG8_BAR; PG8_SCHED;
            PG8_LDA(At, 0, 1); PG8_STAGE(PG8_SB(0, 0), b2, voffB); PG8_STAGE(PG8_SB(0, 1), b2 + hstep, voffB); PG8_STAGE(PG8_SA(0, 0), a2, voffA);
            PG8_WAIT_V(8); PG8_WAIT_L(0); PG8_BAR; PG8_MMA(1, 0, At, B0); PG8_MMA(1, 1, At, B1); PG8_BAR; PG8_SCHED;
            PG8_LDB(B0, 1, 0); PG8_LDB(B1, 1, 1); PG8_SCHED; PG8_LDA(At, 1, 0); PG8_STAGE(PG8_SA(0, 1), a2 + hstep, voffA);
            PG8_WAIT_V(8); PG8_WAIT_L(0); PG8_BAR; PG8_MMA(0, 0, At, B0); PG8_MMA(0, 1, At, B1); PG8_BAR; PG8_SCHED;
            PG8_LDA(At, 1, 1); PG8_STAGE(PG8_SB(1, 0), b3, voffB); PG8_STAGE(PG8_SB(1, 1), b3 + hstep, voffB); PG8_STAGE(PG8_SA(1, 0), a3, voffA);
            PG8_WAIT_V(8); PG8_WAIT_L(0); PG8_BAR; PG8_MMA(1, 0, At, B0); PG8_MMA(1, 1, At, B1); PG8_BAR; PG8_SCHED;
            } else {
            PG8_LDB(B0, 0, 0); PG8_SCHED; PG8_LDA(At, 0, 0); PG8_STAGE(PG8_SA(1, 1), a1 + hstep, voffA);
            PG8_WAIT_L(8); PG8_BAR; PG8_WAIT_L(0); PG8_MMA(0, 0, At, B0); PG8_BAR; PG8_SCHED;
            PG8_LDB(B1, 0, 1); PG8_STAGE(PG8_SB(0, 0), b2, voffB);
            PG8_BAR; PG8_WAIT_L(0); PG8_MMA(0, 1, At, B1); PG8_BAR;
            PG8_LDA(At, 0, 1); PG8_STAGE(PG8_SA(0, 0), a2, voffA);
            PG8_BAR; PG8_WAIT_L(0); PG8_MMA(1, 0, At, B0); PG8_BAR; PG8_SCHED;
            PG8_STAGE(PG8_SB(0, 1), b2 + hstep, voffB);
            PG8_WAIT_V(6); PG8_BAR; PG8_MMA(1, 1, At, B1); PG8_BAR;
            PG8_LDB(B0, 1, 0); PG8_SCHED; PG8_LDA(At, 1, 0); PG8_STAGE(PG8_SA(0, 1), a2 + hstep, voffA);
            PG8_WAIT_L(8); PG8_BAR; PG8_WAIT_L(0); PG8_MMA(0, 0, At, B0); PG8_BAR; PG8_SCHED;
            PG8_LDB(B1, 1, 1); PG8_STAGE(PG8_SB(1, 0), b3, voffB);
            PG8_BAR; PG8_WAIT_L(0); PG8_MMA(0, 1, At, B1); PG8_BAR;
            PG8_LDA(At, 1, 1); PG8_STAGE(PG8_SA(1, 0), a3, voffA);
            PG8_BAR; PG8_WAIT_L(0); PG8_MMA(1, 0, At, B0); PG8_BAR; PG8_SCHED;
            PG8_STAGE(PG8_SB(1, 1), b3 + hstep, voffB);
            PG8_WAIT_V(6); PG8_BAR; PG8_MMA(1, 1, At, B1); PG8_BAR;
            }
        }
        if constexpr (ALIGN_EPI) { if (wr == 0) PG8_BAR; }
        if constexpr (!Epi::AFTER_DRAIN) { E(acc, cur, wr, wc, fr, fq); S.done(cur); }
        if (!has_next) break;
#pragma unroll
        for (int a = 0; a < 2; ++a)
#pragma unroll
            for (int b = 0; b < 2; ++b)
#pragma unroll
                for (int m = 0; m < 4; ++m)
#pragma unroll
                    for (int n = 0; n < 2; ++n) acc[a][b][m][n] = (f32x4){0.f, 0.f, 0.f, 0.f};
        cur = nxt; cA = nA; cB = nB; ++ui;
        if constexpr (ALIGN_EPI) { if (wr == 1) PG8_BAR; }
    }
    PG8_WAIT_V(0);
    if constexpr (!ALIGN_EPI) { if (wr == 0) PG8_BAR; }
    PG8_BAR;
    if constexpr (Epi::AFTER_DRAIN) { E.fused(acc, cur, wr, wc, fr, fq, lds, wid, lane); S.done(cur); }
#undef PG8_SA
#undef PG8_SB
#undef PG8_STAGE
#undef PG8_LDA
#undef PG8_LDB
#undef PG8_MMA
#undef PG8_WAIT_V
#undef PG8_WAIT_L
#undef PG8_BAR
#undef PG8_SCHED
}
}

namespace at {
using pg8::bf16_t;
typedef short bf16x8 __attribute__((ext_vector_type(8)));
typedef short s16x4 __attribute__((ext_vector_type(4)));
typedef float f32x16 __attribute__((ext_vector_type(16)));
typedef float f32x4 __attribute__((ext_vector_type(4)));
typedef float f32x2_t __attribute__((ext_vector_type(2)));
typedef __bf16 bf16x2_t __attribute__((ext_vector_type(2)));
typedef unsigned u32x4 __attribute__((ext_vector_type(4)));
typedef unsigned u32x2 __attribute__((ext_vector_type(2)));
#define AT_LAS __attribute__((address_space(3)))
constexpr int PITCH = 6144, KCOL = 1024, VCOL = 2048, TLAST = 2063;
constexpr float THR = 8.0f;
__device__ __forceinline__ unsigned off_b(unsigned row, unsigned ch) { return 256u * row + 16u * (ch ^ (((row & 3u) << 2) | ((row >> 2) & 3u))); }
__device__ __forceinline__ int crow(int r, int hi) { return (r & 3) + 8 * (r >> 2) + 4 * hi; }
__device__ __forceinline__ unsigned cvtpk(float lo, float hi) { f32x2_t v = {lo, hi}; bf16x2_t b = __builtin_convertvector(v, bf16x2_t); return __builtin_bit_cast(unsigned, b); }
__device__ __forceinline__ float swap_max(float m) { auto rr = __builtin_amdgcn_permlane32_swap(__float_as_uint(m), __float_as_uint(m), false, false); return fmaxf(__uint_as_float(rr[0]), __uint_as_float(rr[1])); }
__device__ __forceinline__ float swap_add(float m) { auto rr = __builtin_amdgcn_permlane32_swap(__float_as_uint(m), __float_as_uint(m), false, false); return __uint_as_float(rr[0]) + __uint_as_float(rr[1]); }
__device__ __forceinline__ s16x4 vtr(AT_LAS const unsigned char* p) { return __builtin_bit_cast(s16x4, __builtin_amdgcn_ds_read_tr16_b64_v4i16((AT_LAS s16x4*)p)); }
#define AT_MFMA(a, b, c) __builtin_amdgcn_mfma_f32_32x32x16_bf16((a), (b), (c), 0, 0, 0)

__device__ __forceinline__ void attn_unit(AT_LAS unsigned char* lds, const bf16_t* __restrict__ proj, const bf16_t* __restrict__ metap, bf16_t* __restrict__ cat,
                                          const float* __restrict__ head_g, int b, int h, int qb, float lam) {
    const int tid = threadIdx.x, lane = tid & 63, r32 = lane & 31, hi = lane >> 5;
    const int wid = __builtin_amdgcn_readfirstlane(tid >> 6), map = wid & 1, qblk = wid >> 1;
    const int qrow_g = b * 2048 + 128 * qb + 32 * qblk + r32;
    const int qp_min = 16 + 128 * qb + 32 * qblk, qp = qp_min + r32, qp_max = qp_min + 31;
    const int NT = 2 * qb + 3;
    const float slope2 = __builtin_amdgcn_exp2f(-(float)(h + 1)) * 1.4426950408889634f;
    const int srow = tid >> 4, sch = tid & 15;
    const unsigned sdst = off_b((unsigned)srow, (unsigned)sch);
    u32x4 kreg[2], vreg[2];
#define AT_LOADT(j) do { _Pragma("unroll") for (int i_ = 0; i_ < 2; ++i_) { int p_ = 64 * (j) + srow + 32 * i_; p_ = p_ > TLAST ? TLAST : p_; \
        const bf16_t* rp_ = (p_ < 16 ? metap + (size_t)p_ * PITCH : proj + (size_t)(b * 2048 + p_ - 16) * PITCH) + h * 128 + sch * 8; \
        kreg[i_] = *(const u32x4*)(rp_ + KCOL); vreg[i_] = *(const u32x4*)(rp_ + VCOL); } } while (0)
#define AT_STORET(buf) do { _Pragma("unroll") for (int i_ = 0; i_ < 2; ++i_) { *(AT_LAS u32x4*)(lds + (buf) * 16384 + i_ * 8192 + sdst) = kreg[i_]; \
        *(AT_LAS u32x4*)(lds + 32768 + (buf) * 16384 + i_ * 8192 + sdst) = vreg[i_]; } } while (0)
    AT_LOADT(0);
    bf16x8 qf[4];
#pragma unroll
    for (int d0 = 0; d0 < 4; ++d0) qf[d0] = *(const bf16x8*)(proj + (size_t)qrow_g * PITCH + h * 128 + map * 64 + 16 * d0 + 8 * hi);
    unsigned koff[4];
    { const unsigned x = (((unsigned)lane & 3u) << 2) | (((unsigned)lane >> 2) & 3u);
#pragma unroll
      for (int d0 = 0; d0 < 4; ++d0) koff[d0] = 256u * (unsigned)r32 + 16u * (((unsigned)(8 * map + 2 * d0 + hi)) ^ x); }
    unsigned voff[2][4];
    { const unsigned q4 = ((unsigned)lane & 15u) >> 2, p = (unsigned)lane & 3u, blk16 = ((unsigned)lane >> 4) & 1u;
#pragma unroll
      for (int t = 0; t < 2; ++t)
#pragma unroll
          for (int c = 0; c < 4; ++c) voff[t][c] = 256u * (4u * (unsigned)hi + q4) + 16u * ((4u * (unsigned)c + 2u * blk16 + (p >> 1)) ^ ((q4 << 2) | ((2u * (unsigned)t + (unsigned)hi) & 3u))) + 8u * (p & 1u); }
    float cvec[16];
#pragma unroll
    for (int r = 0; r < 16; ++r) cvec[r] = slope2 * (float)((r & 3) + 8 * (r >> 2));
    f32x16 O[4];
#pragma unroll
    for (int c = 0; c < 4; ++c)
#pragma unroll
        for (int r = 0; r < 16; ++r) O[c][r] = 0.f;
    float mref = -INFINITY, lsum = 0.f;
    AT_STORET(0);
    __syncthreads();
    for (int j = 0; j < NT; ++j) {
        const int buf = j & 1;
        if (j + 1 < NT) AT_LOADT(j + 1);
        if (64 * j <= qp_max) {
            const float tl = slope2 * (float)(64 * j + 4 * hi - qp);
            f32x16 s0, s1;
#pragma unroll
            for (int r = 0; r < 16; ++r) { s0[r] = tl + cvec[r]; s1[r] = s0[r] + 32.0f * slope2; }
            AT_LAS const unsigned char* kb = lds + buf * 16384;
#pragma unroll
            for (int d0 = 0; d0 < 4; ++d0) {
                const bf16x8 k0 = *(AT_LAS const bf16x8*)(kb + koff[d0]);
                const bf16x8 k1 = *(AT_LAS const bf16x8*)(kb + 8192 + koff[d0]);
                s0 = AT_MFMA(k0, qf[d0], s0); s1 = AT_MFMA(k1, qf[d0], s1);
            }
            if (64 * j + 63 > qp_min) {
#pragma unroll
                for (int r = 0; r < 16; ++r) { const int kp = 64 * j + crow(r, hi); if (kp > qp) s0[r] = -INFINITY; if (kp + 32 > qp) s1[r] = -INFINITY; }
            }
            float mt = fmaxf(s0[0], s1[0]);
#pragma unroll
            for (int r = 1; r < 16; ++r) mt = fmaxf(mt, fmaxf(s0[r], s1[r]));
            mt = swap_max(mt);
            if (__any(mt > mref + THR)) {
                const float mnew = fmaxf(mref, mt);
                const float alpha = __builtin_amdgcn_exp2f(mref - mnew);
                lsum *= alpha;
#pragma unroll
                for (int c = 0; c < 4; ++c)
#pragma unroll
                    for (int r = 0; r < 16; ++r) O[c][r] *= alpha;
                mref = mnew;
            }
            float ps = 0.f;
#pragma unroll
            for (int r = 0; r < 16; ++r) { s0[r] = __builtin_amdgcn_exp2f(s0[r] - mref); s1[r] = __builtin_amdgcn_exp2f(s1[r] - mref); ps += s0[r] + s1[r]; }
            lsum += ps;
            bf16x8 pf[4];
#pragma unroll
            for (int s = 0; s < 4; ++s) { u32x4 w;
                if (s < 2) { w.x = cvtpk(s0[8 * s + 0], s0[8 * s + 1]); w.y = cvtpk(s0[8 * s + 2], s0[8 * s + 3]); w.z = cvtpk(s0[8 * s + 4], s0[8 * s + 5]); w.w = cvtpk(s0[8 * s + 6], s0[8 * s + 7]); }
                else { w.x = cvtpk(s1[8 * s - 16], s1[8 * s - 15]); w.y = cvtpk(s1[8 * s - 14], s1[8 * s - 13]); w.z = cvtpk(s1[8 * s - 12], s1[8 * s - 11]); w.w = cvtpk(s1[8 * s - 10], s1[8 * s - 9]); }
                pf[s] = __builtin_bit_cast(bf16x8, w); }
            AT_LAS const unsigned char* vb = lds + 32768 + buf * 16384;
#pragma unroll
            for (int s = 0; s < 4; ++s)
#pragma unroll
                for (int c = 0; c < 4; ++c) {
                    const s16x4 lo = vtr(vb + (s >> 1) * 8192 + (s & 1) * 4096 + voff[0][c]);
                    const s16x4 hh = vtr(vb + (s >> 1) * 8192 + (s & 1) * 4096 + 2048 + voff[1][c]);
                    const bf16x8 vf = __builtin_shufflevector(lo, hh, 0, 1, 2, 3, 4, 5, 6, 7);
                    O[c] = AT_MFMA(vf, pf[s], O[c]);
                }
        }
        if (j + 1 < NT) AT_STORET(buf ^ 1);
        __syncthreads();
    }
    lsum = swap_add(lsum);
    const float inv = 1.0f / lsum;
    AT_LAS f32x4* xch = (AT_LAS f32x4*)(lds + qblk * 16384) + lane;
    if (map == 1) {
#pragma unroll
        for (int c = 0; c < 4; ++c)
#pragma unroll
            for (int g = 0; g < 4; ++g) xch[(c * 4 + g) * 64] = (f32x4){O[c][4 * g] * inv, O[c][4 * g + 1] * inv, O[c][4 * g + 2] * inv, O[c][4 * g + 3] * inv};
    }
    __syncthreads();
    if (map == 0) {
        float ms = 0.f;
#pragma unroll
        for (int c = 0; c < 4; ++c)
#pragma unroll
            for (int g = 0; g < 4; ++g) { const f32x4 o2 = xch[(c * 4 + g) * 64];
#pragma unroll
                for (int e = 0; e < 4; ++e) { const float o = O[c][4 * g + e] * inv - lam * o2[e]; O[c][4 * g + e] = o; ms += o * o; } }
        ms = swap_add(ms);
        const float rn = __builtin_amdgcn_rsqf(ms * (1.0f / 128.0f) + 1e-5f) * 0.8f;
        bf16_t* orow = cat + (size_t)qrow_g * 2048 + h * 128 + 4 * hi;
#pragma unroll
        for (int c = 0; c < 4; ++c)
#pragma unroll
            for (int g = 0; g < 4; ++g) { const f32x4 hg = *(const f32x4*)(head_g + 32 * c + 8 * g + 4 * hi);
                u32x2 w; w.x = cvtpk(O[c][4 * g] * rn * hg[0], O[c][4 * g + 1] * rn * hg[1]); w.y = cvtpk(O[c][4 * g + 2] * rn * hg[2], O[c][4 * g + 3] * rn * hg[3]);
                *(u32x2*)(orow + 32 * c + 8 * g) = w; }
    }
    __syncthreads();
#undef AT_LOADT
#undef AT_STORET
}
}

namespace cg = cooperative_groups;
#define GAS __attribute__((address_space(1)))
#define LAS __attribute__((address_space(3)))
typedef unsigned short bf16;
typedef unsigned v4u __attribute__((ext_vector_type(4)));
typedef unsigned v2u __attribute__((ext_vector_type(2)));
typedef float f32x4 __attribute__((ext_vector_type(4)));
constexpr int NWAVES = 8;
constexpr int BATCH = 8, SEQ = 2048, DM = 2048, M = BATCH * SEQ, NMETA = 16, INW = 6144, DFF = 5632, NGU = 2 * DFF;
constexpr float NORM_EPS = 1e-6f;
constexpr float C2 = 0.125f * 1.4426950408889634f;
constexpr size_t MiB = 1u << 20;
constexpr size_t WS_CTL = 0, CTL_ZERO_BYTES = 1 * MiB;
constexpr size_t WS_METAP = 1 * MiB;
constexpr size_t WS_MPART = 2 * MiB;
constexpr size_t WS_WIN = 6 * MiB, WS_WOUT = 30 * MiB, WS_WGU = 38 * MiB, WS_WDN = 82 * MiB;
constexpr size_t WS_A = 104 * MiB;
constexpr size_t WS_PROJ = 168 * MiB;
constexpr size_t WS_CAT = 360 * MiB, WS_END = 424 * MiB;
constexpr int LDS_BYTES = 147456;
constexpr int MP_KC = 8, MP_COLS = 5120;

__device__ __forceinline__ float wave_sum(float v) {
#pragma unroll
    for (int o = 1; o < 64; o <<= 1) v += __shfl_xor(v, o);
    return v;
}
__device__ __forceinline__ float bf2f(unsigned short h) { return __uint_as_float(((unsigned)h) << 16); }
#define LDS_WAIT() asm volatile("s_waitcnt lgkmcnt(0)" ::: "memory")

__device__ __forceinline__ void tr_item(const float* __restrict__ W, int N, int k0, int n0, const float* __restrict__ kscale, bf16* __restrict__ out, int out_ld, int out_row0, LAS float* scr, int lane) {
#pragma unroll 16
    for (int i = 0; i < 64; ++i) { float v = W[(size_t)(k0 + i) * N + n0 + lane]; if (kscale) v *= kscale[k0 + i]; scr[i * 65 + lane] = v; }
    LDS_WAIT(); asm volatile("" ::: "memory");
    const int c = lane & 7;
#pragma unroll
    for (int j = 0; j < 8; ++j) { const int n = (lane >> 3) + 8 * j; const LAS float* s = scr + (8 * c) * 65 + n;
        v4u o; o.x = pg8::cvt_pk_bf16(s[0 * 65], s[1 * 65]); o.y = pg8::cvt_pk_bf16(s[2 * 65], s[3 * 65]); o.z = pg8::cvt_pk_bf16(s[4 * 65], s[5 * 65]); o.w = pg8::cvt_pk_bf16(s[6 * 65], s[7 * 65]);
        *(v4u*)(out + (size_t)(out_row0 + n) * out_ld + k0 + 8 * c) = o; }
    LDS_WAIT(); asm volatile("" ::: "memory");
}

struct Args { const float* in[16]; float* out; unsigned char* ws; };

__global__ void __launch_bounds__(NWAVES * 64, 2) hymba_fwd(Args args) {
    extern __shared__ __attribute__((aligned(16))) unsigned char lds_raw[];
    cg::grid_group grid = cg::this_grid();
    LAS unsigned char* lds = (LAS unsigned char*)lds_raw;
    const int tid = threadIdx.x, lane = tid & 63, wave = __builtin_amdgcn_readfirstlane(tid >> 6);
    const int G = gridDim.x, bx = blockIdx.x;
    const int vcu = (G % 8 == 0) ? (bx % 8) * (G / 8) + bx / 8 : bx;
    const int gw = __builtin_amdgcn_readfirstlane(vcu * NWAVES + wave), NGW = G * NWAVES;
    unsigned char* ws = args.ws;
    const float* x = args.in[0]; const float* meta = args.in[1]; const float* g1 = args.in[2]; const float* w_in = args.in[3];
    const float* head_g = args.in[8]; const float* conv_w = args.in[9]; const float* w_out = args.in[10]; const float* g2 = args.in[11];
    const float* w_gate = args.in[12]; const float* w_up = args.in[13]; const float* w_down = args.in[14]; const float* gf = args.in[15];
    float* out = args.out;
    float* ssq1 = (float*)(ws + WS_CTL); float* ssq2 = ssq1 + M;
    bf16* metap = (bf16*)(ws + WS_METAP); float* mpart = (float*)(ws + WS_MPART);
    bf16* Win_t = (bf16*)(ws + WS_WIN); bf16* Wout_t = (bf16*)(ws + WS_WOUT); bf16* Wgu_t = (bf16*)(ws + WS_WGU); bf16* Wdn_t = (bf16*)(ws + WS_WDN);
    bf16* Abuf = (bf16*)(ws + WS_A); bf16* proj = (bf16*)(ws + WS_PROJ); bf16* act = (bf16*)(ws + WS_PROJ); bf16* cat = (bf16*)(ws + WS_CAT);

    {
        for (int task = gw; task < 80 * MP_KC; task += NGW) {
            const int cc = task % 80, kc = task / 80; const int col = 1024 + cc * 64 + lane;
            float acc[16];
#pragma unroll
            for (int r = 0; r < 16; ++r) acc[r] = 0.f;
#pragma unroll 4
            for (int k = kc * 256; k < kc * 256 + 256; ++k) { const float w = w_in[(size_t)k * INW + col] * g1[k];
#pragma unroll
                for (int r = 0; r < 16; ++r) acc[r] = fmaf(meta[r * DM + k], w, acc[r]); }
#pragma unroll
            for (int r = 0; r < 16; ++r) mpart[(size_t)(kc * 16 + r) * MP_COLS + cc * 64 + lane] = acc[r];
        }
        LAS float* scr = (LAS float*)(lds + wave * 16640);
        constexpr int I_IN = 32 * 96, I_OUT = 32 * 32, I_G = 32 * 88, I_D = 88 * 32, NITEMS = I_IN + I_OUT + 2 * I_G + I_D;
        for (int it = gw; it < NITEMS; it += NGW) {
            int r = it;
            if (r < I_IN) { tr_item(w_in, INW, 64 * (r / 96), 64 * (r % 96), nullptr, Win_t, DM, 64 * (r % 96), scr, lane); continue; } r -= I_IN;
            if (r < I_OUT) { tr_item(w_out, DM, 64 * (r / 32), 64 * (r % 32), nullptr, Wout_t, DM, 64 * (r % 32), scr, lane); continue; } r -= I_OUT;
            if (r < I_G) { const int n0 = 64 * (r % 88); tr_item(w_gate, DFF, 64 * (r / 88), n0, g2, Wgu_t, DM, 256 * (n0 / 128) + (n0 % 128), scr, lane); continue; } r -= I_G;
            if (r < I_G) { const int n0 = 64 * (r % 88); tr_item(w_up, DFF, 64 * (r / 88), n0, g2, Wgu_t, DM, 256 * (n0 / 128) + 128 + (n0 % 128), scr, lane); continue; } r -= I_G;
            tr_item(w_down, DM, 64 * (r / 32), 64 * (r % 32), nullptr, Wdn_t, DFF, 64 * (r % 32), scr, lane);
        }
        for (int m = gw; m < M; m += NGW) {
            const f32x4* xr = (const f32x4*)(x + (size_t)m * DM) + lane; f32x4 v[8]; float s = 0.f;
#pragma unroll
            for (int j = 0; j < 8; ++j) { v[j] = xr[64 * j]; s += (v[j].x * v[j].x + v[j].y * v[j].y) + (v[j].z * v[j].z + v[j].w * v[j].w); }
            const float rs = __builtin_amdgcn_rsqf(wave_sum(s) * (1.0f / DM) + NORM_EPS);
            v2u* o8 = (v2u*)(Abuf + (size_t)m * DM) + lane;
#pragma unroll
            for (int j = 0; j < 8; ++j) { const f32x4 g = ((const f32x4*)g1)[64 * j + lane]; v2u w; w.x = pg8::cvt_pk_bf16(v[j].x * rs * g.x, v[j].y * rs * g.y); w.y = pg8::cvt_pk_bf16(v[j].z * rs * g.z, v[j].w * rs * g.w); o8[64 * j] = w; }
        }
    }
    grid.sync();

    if (bx < 16) {
        const int r = bx; float s = 0.f;
        for (int k = lane; k < DM; k += 64) { const float v = meta[r * DM + k]; s += v * v; }
        const float rs = __builtin_amdgcn_rsqf(wave_sum(s) * (1.0f / DM) + NORM_EPS);
        for (int c = tid; c < MP_COLS; c += NWAVES * 64) { float a = 0.f;
#pragma unroll
            for (int kc = 0; kc < MP_KC; ++kc) a += mpart[(size_t)(kc * 16 + r) * MP_COLS + c];
            metap[(size_t)r * INW + 1024 + c] = (bf16)(pg8::cvt_pk_bf16(a * rs, 0.f) & 0xffffu); }
    }
    {
        pg8::Gemm g{Abuf, Win_t, M, INW, DM}; pg8::StaticOrder S; S.init(M, INW, G, bx);
        pg8::EpiProj E{proj, C2};
        pg8::gemm_phase<pg8::EpiProj, pg8::StaticOrder, true, true>(lds, g, S, E);
    }
    grid.sync();

    {
        float lam;
        { const float a = args.in[4][lane] * args.in[5][lane], c = args.in[6][lane] * args.in[7][lane];
          lam = __expf(wave_sum(a)) - __expf(wave_sum(c)) + 0.2f; }
        for (int pi = vcu; pi < 512; pi += G) {
            const int bh = pi >> 3, s = pi & 7;
            at::attn_unit(lds, proj, metap, cat, head_g, bh >> 3, bh & 7, 15 - s, lam);
            at::attn_unit(lds, proj, metap, cat, head_g, bh >> 3, bh & 7, s, lam);
        }
        for (int idx = vcu * (NWAVES * 64) + tid; idx < M * 128; idx += G * NWAVES * 64) {
            const int row = idx >> 7, c8 = (idx & 127) * 8, s = row & (SEQ - 1);
            const bf16* r0 = proj + (size_t)row * INW;
            const bf16* r1 = s >= 1 ? r0 - INW : metap + (size_t)15 * INW;
            const bf16* r2 = s >= 2 ? r0 - 2 * INW : metap + (size_t)(14 + s) * INW;
            const v4u bgv = *(const v4u*)(r0 + 3072 + c8), c0v = *(const v4u*)(r0 + 4096 + c8), h0v = *(const v4u*)(r0 + 5120 + c8);
            const v4u c1v = *(const v4u*)(r1 + 4096 + c8), h1v = *(const v4u*)(r1 + 5120 + c8), c2v = *(const v4u*)(r2 + 4096 + c8), h2v = *(const v4u*)(r2 + 5120 + c8);
            float y[8];
#pragma unroll
            for (int e = 0; e < 8; ++e) {
                const int w = e >> 1, sh = (e & 1) * 16;
                const float bg = __uint_as_float((bgv[w] >> sh) << 16), u0 = __uint_as_float((c0v[w] >> sh) << 16) * __uint_as_float((h0v[w] >> sh) << 16);
                const float u1 = __uint_as_float((c1v[w] >> sh) << 16) * __uint_as_float((h1v[w] >> sh) << 16), u2 = __uint_as_float((c2v[w] >> sh) << 16) * __uint_as_float((h2v[w] >> sh) << 16);
                y[e] = bg * (conv_w[c8 + e] * u2 + conv_w[1024 + c8 + e] * u1 + conv_w[2048 + c8 + e] * u0);
            }
            v4u o; o.x = pg8::cvt_pk_bf16(y[0], y[1]); o.y = pg8::cvt_pk_bf16(y[2], y[3]); o.z = pg8::cvt_pk_bf16(y[4], y[5]); o.w = pg8::cvt_pk_bf16(y[6], y[7]);
            *(v4u*)(cat + (size_t)row * DM + 1024 + c8) = o;
        }
    }
    grid.sync();

    {
        pg8::Gemm g{cat, Wout_t, M, DM, DM}; pg8::StaticOrder S; S.init(M, DM, G, bx);
        pg8::EpiRes<true> E{x, out, Abuf, ssq1};
        pg8::gemm_phase<pg8::EpiRes<true>, pg8::StaticOrder, true, true>(lds, g, S, E);
    }
    grid.sync();

    {
        pg8::Gemm g{Abuf, Wgu_t, M, NGU, DM}; pg8::StaticOrder S; S.init(M, NGU, G, bx);
        pg8::EpiGU E{act, ssq1};
        pg8::gemm_phase<pg8::EpiGU, pg8::StaticOrder, true, true>(lds, g, S, E);
    }
    grid.sync();

    {
        pg8::Gemm g{act, Wdn_t, M, DM, DFF}; pg8::StaticOrder S; S.init(M, DM, G, bx);
        pg8::EpiRes<false> E{out, out, nullptr, ssq2};
        pg8::gemm_phase<pg8::EpiRes<false>, pg8::StaticOrder, true, true>(lds, g, S, E);
    }
    grid.sync();

    for (int m = gw; m < M; m += NGW) {
        const float rs = __builtin_amdgcn_rsqf(ssq2[m] * (1.0f / DM) + NORM_EPS);
        f32x4* o = (f32x4*)(out + (size_t)m * DM) + lane;
#pragma unroll
        for (int j = 0; j < 8; ++j) { const f32x4 g = ((const f32x4*)gf)[64 * j + lane]; f32x4 v = o[64 * j]; v.x *= rs * g.x; v.y *= rs * g.y; v.z *= rs * g.z; v.w *= rs * g.w; o[64 * j] = v; }
    }
}

extern "C" void kernel_launch(void* const* d_in, const int* in_sizes, int n_in, void* d_out, int out_size, void* d_ws, size_t ws_size, hipStream_t stream) {
    static int grid_blocks = 0;
    if (grid_blocks == 0) {
        if (n_in != 16 || in_sizes[0] != M * DM || out_size != M * DM || ws_size < WS_END) { fprintf(stderr, "kernel_launch: unexpected shapes (n_in %d, in0 %d, out %d, ws %zu)\n", n_in, n_in > 0 ? in_sizes[0] : -1, out_size, ws_size); grid_blocks = -1; return; }
        int dev = 0, cus = 0, per_cu = 0;
        (void)hipGetDevice(&dev); (void)hipDeviceGetAttribute(&cus, hipDeviceAttributeMultiprocessorCount, dev);
        if (hipFuncSetAttribute((const void*)hymba_fwd, hipFuncAttributeMaxDynamicSharedMemorySize, LDS_BYTES) != hipSuccess) fprintf(stderr, "kernel_launch: hipFuncSetAttribute failed\n");
        if (hipOccupancyMaxActiveBlocksPerMultiprocessor(&per_cu, (const void*)hymba_fwd, NWAVES * 64, LDS_BYTES) != hipSuccess || per_cu < 1) { fprintf(stderr, "kernel_launch: occupancy query gave %d\n", per_cu); per_cu = 1; }
        (void)hipGetLastError();
        grid_blocks = cus * per_cu;
    }
    if (grid_blocks < 0) return;
    (void)hipMemsetAsync((char*)d_ws + WS_CTL, 0, CTL_ZERO_BYTES, stream);
    Args a{};
    for (int i = 0; i < 16; ++i) a.in[i] = (const float*)d_in[i];
    a.out = (float*)d_out; a.ws = (unsigned char*)d_ws;
    void* kargs[] = {&a};
    hipError_t e = hipLaunchCooperativeKernel((const void*)hymba_fwd, dim3(grid_blocks), dim3(NWAVES * 64), kargs, LDS_BYTES, stream);
    if (e != hipSuccess) fprintf(stderr, "cooperative launch failed: %s (grid %d)\n", hipGetErrorString(e), grid_blocks);
}
```

```cpp
#include <hip/hip_runtime.h>
#include <hip/hip_cooperative_groups.h>
#include <cstdio>
#include <cstdint>
#include <cmath>
namespace pg8 {
#define PG8_LAS __attribute__((address_space(3)))
typedef unsigned short bf16_t;
typedef short bf16x8 __attribute__((ext_vector_type(8)));
typedef float f32x4 __attribute__((ext_vector_type(4)));
typedef unsigned u32x4 __attribute__((ext_vector_type(4)));
constexpr int BM = 256, BK = 64, HALF = 128, HTB = HALF * BK * 2  , STAGE_BYTES = 8 * HTB, NXCD = 8, WGM = 8;

__host__ __device__ __forceinline__ int lds_byte(int r, int c) { const int st = (r >> 4) * 2 + (c >> 5), rr = r & 15, cc = c & 31, ob = rr * 64 + cc * 2; return st * 1024 + (ob ^ (((ob >> 9) & 1) << 5)); }
__host__ __device__ __forceinline__ void stage_rc(int b, int& R, int& C) { const int st = b / 1024, sb = b % 1024, swz = sb ^ (((sb >> 9) & 1) << 5); R = (st >> 1) * 16 + swz / 64; C = (st & 1) * 32 + (swz % 64) / 2; }
__host__ __device__ __forceinline__ int perm32(int rho) { const int n = rho >> 4, i = rho & 15; return 8 * (i >> 2) + 4 * n + (i & 3); }

struct Unit { int pm, pn; };
struct Gemm { const bf16_t* A; const bf16_t* Bt; int M, N, K; };

struct StaticOrder {
    int nM, nN, nwg, G, c, reps = 1;
    __host__ __device__ void init(int M, int N, int G_, int c_) { nM = M / BM; nN = N / BM; nwg = nM * nN; G = G_; c = c_; }
    __host__ __device__ bool next(int i, Unit& u) const {
        const long L = (long)i * G + c; if (L >= (long)nwg * reps) return false;
        int wgid = (int)(L % nwg); { const int q = nwg / NXCD, r = nwg % NXCD, xcd = wgid % NXCD, off = wgid / NXCD; wgid = (xcd < r ? xcd * (q + 1) : r * (q + 1) + (xcd - r) * q) + off; }
        const int nig = WGM * nN, gid = wgid / nig, fm = gid * WGM, gsz = (nM - fm) < WGM ? (nM - fm) : WGM;
        u.pm = fm + ((wgid % nig) % gsz); u.pn = (wgid % nig) / gsz; return true;
    }
    __device__ __forceinline__ void a_ready(const Unit&) const {}
    __device__ __forceinline__ void done(const Unit&) const {}
};

__device__ __forceinline__ unsigned cvt_pk_bf16(float lo, float hi) { unsigned r; asm volatile("v_cvt_pk_bf16_f32 %0, %1, %2" : "=v"(r) : "v"(lo), "v"(hi)); return r; }
typedef float f32x2 __attribute__((ext_vector_type(2)));
struct EpiProj {
    static constexpr bool PERM = true, AFTER_DRAIN = false;
    bf16_t* O; float qscale;
    __device__ __forceinline__ void operator()(const f32x4 (&acc)[2][2][4][2], const Unit& u, int wr, int wc, int fr, int fq) const {
        const int row0 = u.pm * BM + wr * 64 + fr; const int colt = u.pn * BM;
        const float sc = (colt < 1024) ? qscale : 1.f;
        const int col0 = colt + wc * 32 + 8 * fq;
#pragma unroll
        for (int ai = 0; ai < 2; ++ai)
#pragma unroll
            for (int m = 0; m < 4; ++m) { bf16_t* rowp = O + (size_t)(row0 + ai * HALF + m * 16) * 6144 + col0;
#pragma unroll
                for (int bj = 0; bj < 2; ++bj) { const f32x4 v0 = acc[ai][bj][m][0] * sc, v1 = acc[ai][bj][m][1] * sc;
                    u32x4 w; w.x = cvt_pk_bf16(v0[0], v0[1]); w.y = cvt_pk_bf16(v0[2], v0[3]); w.z = cvt_pk_bf16(v1[0], v1[1]); w.w = cvt_pk_bf16(v1[2], v1[3]);
                    *(u32x4*)(rowp + bj * HALF) = w; } }
    }
};
struct EpiRes1 {
    static constexpr bool PERM = true, AFTER_DRAIN = false;
    const float* __restrict__ X; bf16_t* __restrict__ Hb; float* __restrict__ ssq;
    __device__ __forceinline__ void operator()(const f32x4 (&acc)[2][2][4][2], const Unit& u, int wr, int wc, int fr, int fq) const {
        const int row0 = u.pm * BM + wr * 64 + fr; const int col0 = u.pn * BM + wc * 32 + 8 * fq;
#pragma unroll
        for (int ai = 0; ai < 2; ++ai) {
            f32x4 pre[4][2][2];
#pragma unroll
            for (int m = 0; m < 4; ++m)
#pragma unroll
                for (int bj = 0; bj < 2; ++bj) { const size_t off = (size_t)(row0 + ai * HALF + m * 16) * 2048 + col0 + bj * HALF;
                    pre[m][bj][0] = __builtin_nontemporal_load((const f32x4*)(X + off)); pre[m][bj][1] = __builtin_nontemporal_load((const f32x4*)(X + off + 4)); }
            asm volatile("" ::: "memory");
#pragma unroll
            for (int m = 0; m < 4; ++m) { const int row = row0 + ai * HALF + m * 16; float ss = 0.f;
#pragma unroll
                for (int bj = 0; bj < 2; ++bj) { const size_t off = (size_t)row * 2048 + col0 + bj * HALF;
                    const f32x4 v0 = acc[ai][bj][m][0] + pre[m][bj][0], v1 = acc[ai][bj][m][1] + pre[m][bj][1];
                    u32x4 w; w.x = cvt_pk_bf16(v0[0], v0[1]); w.y = cvt_pk_bf16(v0[2], v0[3]); w.z = cvt_pk_bf16(v1[0], v1[1]); w.w = cvt_pk_bf16(v1[2], v1[3]); *(u32x4*)(Hb + off) = w;
                    ss += (v0[0] * v0[0] + v0[1] * v0[1]) + (v0[2] * v0[2] + v0[3] * v0[3]) + (v1[0] * v1[0] + v1[1] * v1[1]) + (v1[2] * v1[2] + v1[3] * v1[3]); }
                ss += __shfl_xor(ss, 16); ss += __shfl_xor(ss, 32);
                if (fq == 0) atomicAdd(ssq + row, ss); }
        }
    }
};
__device__ __forceinline__ float bflo(unsigned w) { return __uint_as_float(w << 16); }
__device__ __forceinline__ float bfhi(unsigned w) { return __uint_as_float(w & 0xffff0000u); }
struct EpiRes2 {
    static constexpr bool PERM = true, AFTER_DRAIN = false;
    const bf16_t* __restrict__ X; bf16_t* __restrict__ Hb; float* __restrict__ ssq;
    __device__ __forceinline__ void operator()(const f32x4 (&acc)[2][2][4][2], const Unit& u, int wr, int wc, int fr, int fq) const {
        const int row0 = u.pm * BM + wr * 64 + fr; const int col0 = u.pn * BM + wc * 32 + 8 * fq;
        u32x4 pre[2][4][2];
#pragma unroll
        for (int ai = 0; ai < 2; ++ai)
#pragma unroll
            for (int m = 0; m < 4; ++m)
#pragma unroll
                for (int bj = 0; bj < 2; ++bj) pre[ai][m][bj] = *(const u32x4*)(X + (size_t)(row0 + ai * HALF + m * 16) * 2048 + col0 + bj * HALF);
        asm volatile("" ::: "memory");
#pragma unroll
        for (int ai = 0; ai < 2; ++ai)
#pragma unroll
            for (int m = 0; m < 4; ++m) { const int row = row0 + ai * HALF + m * 16; float ss = 0.f;
#pragma unroll
                for (int bj = 0; bj < 2; ++bj) { const size_t off = (size_t)row * 2048 + col0 + bj * HALF; const u32x4 xr = pre[ai][m][bj];
                    const f32x4 v0 = acc[ai][bj][m][0] + (f32x4){bflo(xr.x), bfhi(xr.x), bflo(xr.y), bfhi(xr.y)}, v1 = acc[ai][bj][m][1] + (f32x4){bflo(xr.z), bfhi(xr.z), bflo(xr.w), bfhi(xr.w)};
                    u32x4 w; w.x = cvt_pk_bf16(v0[0], v0[1]); w.y = cvt_pk_bf16(v0[2], v0[3]); w.z = cvt_pk_bf16(v1[0], v1[1]); w.w = cvt_pk_bf16(v1[2], v1[3]); *(u32x4*)(Hb + off) = w;
                    ss += (v0[0] * v0[0] + v0[1] * v0[1]) + (v0[2] * v0[2] + v0[3] * v0[3]) + (v1[0] * v1[0] + v1[1] * v1[1]) + (v1[2] * v1[2] + v1[3] * v1[3]); }
                ss += __shfl_xor(ss, 16); ss += __shfl_xor(ss, 32);
                if (fq == 0) atomicAdd(ssq + row, ss); }
    }
};
struct EpiGU {
    static constexpr bool PERM = true, AFTER_DRAIN = false;
    bf16_t* O; const float* ssq;
    __device__ __forceinline__ void operator()(const f32x4 (&acc)[2][2][4][2], const Unit& u, int wr, int wc, int fr, int fq) const {
        const int row0 = u.pm * BM + wr * 64 + fr; const int col0 = u.pn * HALF + wc * 32 + 8 * fq;
#pragma unroll
        for (int ai = 0; ai < 2; ++ai)
#pragma unroll
            for (int m = 0; m < 4; ++m) { const int row = row0 + ai * HALF + m * 16;
                const float rs = __builtin_amdgcn_rsqf(ssq[row] * (1.0f / 2048.0f) + 1e-6f);
                float a[8];
#pragma unroll
                for (int n = 0; n < 2; ++n)
#pragma unroll
                    for (int e = 0; e < 4; ++e) { const float g = acc[ai][0][m][n][e] * rs, up = acc[ai][1][m][n][e] * rs;
                        a[n * 4 + e] = g * __builtin_amdgcn_rcpf(1.0f + __builtin_amdgcn_exp2f(-1.4426950408889634f * g)) * up; }
                u32x4 w; w.x = cvt_pk_bf16(a[0], a[1]); w.y = cvt_pk_bf16(a[2], a[3]); w.z = cvt_pk_bf16(a[4], a[5]); w.w = cvt_pk_bf16(a[6], a[7]);
                *(u32x4*)(O + (size_t)row * 5632 + col0) = w; }
    }
};
template <class Epi, class Sched, bool ALIGN_EPI = false, bool SP2 = false>
__device__ __forceinline__ void gemm_phase(PG8_LAS unsigned char* lds, const Gemm g, const Sched& S, const Epi& E) {
    const int tid = threadIdx.x, wid = __builtin_amdgcn_readfirstlane(tid >> 6), lane = tid & 63, wr = wid >> 2, wc = wid & 3, fr = lane & 15, fq = lane >> 4;
    const int K = g.K, nt = K / BK;
    unsigned voffA[2], voffB[2];
#pragma unroll
    for (int i = 0; i < 2; ++i) { int R, C; stage_rc(tid * 16 + i * 8192, R, C); const int Rb = Epi::PERM ? ((R & ~31) + perm32(R & 31)) : R;
        voffA[i] = (unsigned)(R * K + C) * 2u; voffB[i] = (unsigned)(Rb * K + C) * 2u; }
    const size_t kstep = (size_t)(BK * 2);
    const size_t hstep = (size_t)HALF * K * 2;
    const size_t tstep = 2 * hstep;
    const unsigned ldsw = (unsigned)wid * 1024u;
    const int aoff = lds_byte(wr * 64 + fr, fq * 8), boff = lds_byte(wc * 32 + fr, fq * 8);
#define PG8_SA(b, h) (((b) * 2 + (h)) * HTB)
#define PG8_SB(b, h) ((4 + (b) * 2 + (h)) * HTB)
#define PG8_STAGE(bufoff, gbase, voff) do { _Pragma("unroll") for (int _i = 0; _i < 2; ++_i) \
        __builtin_amdgcn_global_load_lds((const unsigned*)((const char*)(gbase) + (voff)[_i]), (PG8_LAS unsigned*)(lds + (bufoff) + ldsw + _i * 8192), 16, 0, 0); } while (0)
#define PG8_LDA(dst, b, h) do { _Pragma("unroll") for (int m = 0; m < 4; ++m) _Pragma("unroll") for (int k = 0; k < 2; ++k) dst[m][k] = *(const PG8_LAS bf16x8*)(lds + PG8_SA(b, h) + aoff + m * 2048 + k * 1024); } while (0)
#define PG8_LDB(dst, b, h) do { _Pragma("unroll") for (int n = 0; n < 2; ++n) _Pragma("unroll") for (int k = 0; k < 2; ++k) dst[n][k] = *(const PG8_LAS bf16x8*)(lds + PG8_SB(b, h) + boff + n * 2048 + k * 1024); } while (0)
#define PG8_MMA(ai, bj, At, Bt) do { __builtin_amdgcn_s_setprio(1); _Pragma("unroll") for (int m = 0; m < 4; ++m) _Pragma("unroll") for (int n = 0; n < 2; ++n) _Pragma("unroll") for (int k = 0; k < 2; ++k) \
        acc[ai][bj][m][n] = __builtin_amdgcn_mfma_f32_16x16x32_bf16(Bt[n][k], At[m][k], acc[ai][bj][m][n], 0, 0, 0); __builtin_amdgcn_s_setprio(0); } while (0)
#define PG8_WAIT_V(n) asm volatile("s_waitcnt vmcnt(" #n ")" ::: "memory")
#define PG8_WAIT_L(n) asm volatile("s_waitcnt lgkmcnt(" #n ")" ::: "memory")
#define PG8_BAR __builtin_amdgcn_s_barrier()
#define PG8_SCHED __builtin_amdgcn_sched_barrier(0)
    Unit cur, nxt; int ui = 0;
    if (!S.next(0, cur)) return;
    f32x4 acc[2][2][4][2];
#pragma unroll
    for (int a = 0; a < 2; ++a)
#pragma unroll
        for (int b = 0; b < 2; ++b)
#pragma unroll
            for (int m = 0; m < 4; ++m)
#pragma unroll
                for (int n = 0; n < 2; ++n) acc[a][b][m][n] = (f32x4){0.f, 0.f, 0.f, 0.f};
    bf16x8 At[4][2], B0[2][2], B1[2][2];
    const char* cA = (const char*)g.A + (size_t)cur.pm * tstep; const char* cB = (const char*)g.Bt + (size_t)cur.pn * tstep;
    S.a_ready(cur);
    if constexpr (SP2) {
        PG8_STAGE(PG8_SB(0, 0), cB, voffB); PG8_STAGE(PG8_SB(0, 1), cB + hstep, voffB); PG8_STAGE(PG8_SA(0, 0), cA, voffA); PG8_STAGE(PG8_SA(0, 1), cA + hstep, voffA);
        if (wr == 1) PG8_BAR;
        PG8_WAIT_V(2); PG8_BAR;
        PG8_STAGE(PG8_SB(1, 0), cB + kstep, voffB); PG8_STAGE(PG8_SA(1, 0), cA + kstep, voffA); PG8_STAGE(PG8_SB(1, 1), cB + hstep + kstep, voffB);
        PG8_WAIT_V(6); PG8_BAR;
    } else {
        PG8_STAGE(PG8_SB(0, 0), cB, voffB); PG8_STAGE(PG8_SA(0, 0), cA, voffA); PG8_STAGE(PG8_SB(0, 1), cB + hstep, voffB); PG8_STAGE(PG8_SA(0, 1), cA + hstep, voffA);
        if (wr == 1) PG8_BAR;
        PG8_WAIT_V(4); PG8_BAR;
        PG8_STAGE(PG8_SB(1, 0), cB + kstep, voffB); PG8_STAGE(PG8_SA(1, 0), cA + kstep, voffA); PG8_STAGE(PG8_SB(1, 1), cB + hstep + kstep, voffB);
        PG8_WAIT_V(6); PG8_BAR;
    }
    for (;;) {
        const bool has_next = S.next(ui + 1, nxt);
        const char* nA = has_next ? (const char*)g.A + (size_t)nxt.pm * tstep : cA; const char* nB = has_next ? (const char*)g.Bt + (size_t)nxt.pn * tstep : cB;
        for (int t = 0; t < nt; t += 2) {
            const bool last = (t == nt - 2);
            const char* a1 = cA + (size_t)(t + 1) * kstep;
            const char* a2 = last ? nA : cA + (size_t)(t + 2) * kstep; const char* b2 = last ? nB : cB + (size_t)(t + 2) * kstep;
            const char* a3 = a2 + kstep; const char* b3 = b2 + kstep;
            if (last && has_next) S.a_ready(nxt);
            if constexpr (SP2) {
            PG8_LDB(B0, 0, 0); PG8_LDB(B1, 0, 1); PG8_SCHED; PG8_LDA(At, 0, 0); PG8_STAGE(PG8_SA(1, 1), a1 + hstep, voffA);
            PG8_WAIT_V(8); PG8_WAIT_L(0); PG8_BAR; PG8_MMA(0, 0, At, B0); PG8_MMA(0, 1, At, B1); PG8_BAR; PG8_SCHED;
            PG8_LDA(At, 0, 1); PG8_STAGE(PG8_SB(0, 0), b2, voffB); PG8_STAGE(PG8_SB(0, 1), b2 + hstep, voffB); PG8_STAGE(PG8_SA(0, 0), a2, voffA);
            PG8_WAIT_V(8); PG8_WAIT_L(0); PG8_BAR; PG8_MMA(1, 0, At, B0); PG8_MMA(1, 1, At, B1); PG8_BAR; PG8_SCHED;
            PG8_LDB(B0, 1, 0); PG8_LDB(B1, 1, 1); PG8_SCHED; PG8_LDA(At, 1, 0); PG8_STAGE(PG8_SA(0, 1), a2 + hstep, voffA);
            PG8_WAIT_V(8); PG8_WAIT_L(0); PG8_BAR; PG8_MMA(0, 0, At, B0); PG8_MMA(0, 1, At, B1); PG8_BAR; PG8_SCHED;
            PG8_LDA(At, 1, 1); PG8_STAGE(PG8_SB(1, 0), b3, voffB); PG8_STAGE(PG8_SB(1, 1), b3 + hstep, voffB); PG8_STAGE(PG8_SA(1, 0), a3, voffA);
            PG8_WAIT_V(8); PG8_WAIT_L(0); PG8_BAR; PG8_MMA(1, 0, At, B0); PG8_MMA(1, 1, At, B1); PG8_BAR; PG8_SCHED;
            } else {
            PG8_LDB(B0, 0, 0); PG8_SCHED; PG8_LDA(At, 0, 0); PG8_STAGE(PG8_SA(1, 1), a1 + hstep, voffA);
            PG8_WAIT_L(8); PG8_BAR; PG8_WAIT_L(0); PG8_MMA(0, 0, At, B0); PG8_BAR; PG8_SCHED;
            PG8_LDB(B1, 0, 1); PG8_STAGE(PG8_SB(0, 0), b2, voffB);
            PG8_BAR; PG8_WAIT_L(0); PG8_MMA(0, 1, At, B1); PG8_BAR;
            PG8_LDA(At, 0, 1); PG8_STAGE(PG8_SA(0, 0), a2, voffA);
            PG8_BAR; PG8_WAIT_L(0); PG8_MMA(1, 0, At, B0); PG8_BAR; PG8_SCHED;
            PG8_STAGE(PG8_SB(0, 1), b2 + hstep, voffB);
            PG8_WAIT_V(6); PG8_BAR; PG8_MMA(1, 1, At, B1); PG8_BAR;
            PG8_LDB(B0, 1, 0); PG8_SCHED; PG8_LDA(At, 1, 0); PG8_STAGE(PG8_SA(0, 1), a2 + hstep, voffA);
            PG8_WAIT_L(8); PG8_BAR; PG8_WAIT_L(0); PG8_MMA(0, 0, At, B0); PG8_BAR; PG8_SCHED;
            PG8_LDB(B1, 1, 1); PG8_STAGE(PG8_SB(1, 0), b3, voffB);
            PG8_BAR; PG8_WAIT_L(0); PG8_MMA(0, 1, At, B1); PG8_BAR;
            PG8_LDA(At, 1, 1); PG8_STAGE(PG8_SA(1, 0), a3, voffA);
            PG8_BAR; PG8_WAIT_L(0); PG8_MMA(1, 0, At, B0); PG8_BAR; PG8_SCHED;
            PG8_STAGE(PG8_SB(1, 1), b3 + hstep, voffB);
            PG8_WAIT_V(6); PG8_BAR; PG8_MMA(1, 1, At, B1); PG8_BAR;
            }
        }
        if constexpr (ALIGN_EPI) { if (wr == 0) PG8_BAR; }
        if constexpr (!Epi::AFTER_DRAIN) { E(acc, cur, wr, wc, fr, fq); S.done(cur); }
        if (!has_next) break;
#pragma unroll
        for (int a = 0; a < 2; ++a)
#pragma unroll
            for (int b = 0; b < 2; ++b)
#pragma unroll
                for (int m = 0; m < 4; ++m)
#pragma unroll
                    for (int n = 0; n < 2; ++n) acc[a][b][m][n] = (f32x4){0.f, 0.f, 0.f, 0.f};
        cur = nxt; cA = nA; cB = nB; ++ui;
        if constexpr (ALIGN_EPI) { if (wr == 1) PG8_BAR; }
    }
    PG8_WAIT_V(0);
    if constexpr (!ALIGN_EPI) { if (wr == 0) PG8_BAR; }
    PG8_BAR;
    if constexpr (Epi::AFTER_DRAIN) { E.fused(acc, cur, wr, wc, fr, fq, lds, wid, lane); S.done(cur); }
#undef PG8_SA
#undef PG8_SB
#undef PG8_STAGE
#undef PG8_LDA
#undef PG8_LDB
#undef PG8_MMA
#undef PG8_WAIT_V
#undef PG8_WAIT_L
#undef PG8_BAR
#undef PG8_SCHED
}
}

namespace at {
using pg8::bf16_t;
typedef short bf16x8 __attribute__((ext_vector_type(8)));
typedef short s16x4 __attribute__((ext_vector_type(4)));
typedef float f32x16 __attribute__((ext_vector_type(16)));
typedef float f32x4 __attribute__((ext_vector_type(4)));
typedef float f32x2_t __attribute__((ext_vector_type(2)));
typedef __bf16 bf16x2_t __attribute__((ext_vector_type(2)));
typedef unsigned u32x4 __attribute__((ext_vector_type(4)));
typedef unsigned u32x2 __attribute__((ext_vector_type(2)));
#define AT_LAS __attribute__((address_space(3)))
constexpr int PITCH = 6144, KCOL = 1024, VCOL = 2048, TLAST = 2063;
constexpr float THR = 8.0f;
__device__ __forceinline__ unsigned off_b(unsigned row, unsigned ch) { return 256u * row + 16u * (ch ^ (((row & 3u) << 2) | ((row >> 2) & 3u))); }
__device__ __forceinline__ int crow(int r, int hi) { return (r & 3) + 8 * (r >> 2) + 4 * hi; }
__device__ __forceinline__ unsigned cvtpk(float lo, float hi) { f32x2_t v = {lo, hi}; bf16x2_t b = __builtin_convertvector(v, bf16x2_t); return __builtin_bit_cast(unsigned, b); }
__device__ __forceinline__ float swap_max(float m) { auto rr = __builtin_amdgcn_permlane32_swap(__float_as_uint(m), __float_as_uint(m), false, false); return fmaxf(__uint_as_float(rr[0]), __uint_as_float(rr[1])); }
__device__ __forceinline__ float swap_add(float m) { auto rr = __builtin_amdgcn_permlane32_swap(__float_as_uint(m), __float_as_uint(m), false, false); return __uint_as_float(rr[0]) + __uint_as_float(rr[1]); }
__device__ __forceinline__ s16x4 vtr(AT_LAS const unsigned char* p) { return __builtin_bit_cast(s16x4, __builtin_amdgcn_ds_read_tr16_b64_v4i16((AT_LAS s16x4*)p)); }
#define AT_MFMA(a, b, c) __builtin_amdgcn_mfma_f32_32x32x16_bf16((a), (b), (c), 0, 0, 0)

__device__ __forceinline__ void attn_unit(AT_LAS unsigned char* lds, const bf16_t* __restrict__ proj, const bf16_t* __restrict__ metap, bf16_t* __restrict__ cat,
                                          const float* __restrict__ head_g, int b, int h, int qb, float lam) {
    const int tid = threadIdx.x, lane = tid & 63, r32 = lane & 31, hi = lane >> 5;
    const int wid = __builtin_amdgcn_readfirstlane(tid >> 6), map = wid & 1, qblk = wid >> 1;
    const int qrow_g = b * 2048 + 128 * qb + 32 * qblk + r32;
    const int qp_min = 16 + 128 * qb + 32 * qblk, qp = qp_min + r32, qp_max = qp_min + 31;
    const int NT = 2 * qb + 3;
    const float slope2 = __builtin_amdgcn_exp2f(-(float)(h + 1)) * 1.4426950408889634f;
    const int srow = tid >> 4, sch = tid & 15;
    const unsigned sdst = off_b((unsigned)srow, (unsigned)sch);
    u32x4 kreg[2], vreg[2];
#define AT_LOADT(j) do { _Pragma("unroll") for (int i_ = 0; i_ < 2; ++i_) { int p_ = 64 * (j) + srow + 32 * i_; p_ = p_ > TLAST ? TLAST : p_; \
        const bf16_t* rp_ = (p_ < 16 ? metap + (size_t)p_ * PITCH : proj + (size_t)(b * 2048 + p_ - 16) * PITCH) + h * 128 + sch * 8; \
        kreg[i_] = *(const u32x4*)(rp_ + KCOL); vreg[i_] = *(const u32x4*)(rp_ + VCOL); } } while (0)
#define AT_STORET(buf) do { _Pragma("unroll") for (int i_ = 0; i_ < 2; ++i_) { *(AT_LAS u32x4*)(lds + (buf) * 16384 + i_ * 8192 + sdst) = kreg[i_]; \
        *(AT_LAS u32x4*)(lds + 32768 + (buf) * 16384 + i_ * 8192 + sdst) = vreg[i_]; } } while (0)
    AT_LOADT(0);
    bf16x8 qf[4];
#pragma unroll
    for (int d0 = 0; d0 < 4; ++d0) qf[d0] = *(const bf16x8*)(proj + (size_t)qrow_g * PITCH + h * 128 + map * 64 + 16 * d0 + 8 * hi);
    unsigned koff[4];
    { const unsigned x = (((unsigned)lane & 3u) << 2) | (((unsigned)lane >> 2) & 3u);
#pragma unroll
      for (int d0 = 0; d0 < 4; ++d0) koff[d0] = 256u * (unsigned)r32 + 16u * (((unsigned)(8 * map + 2 * d0 + hi)) ^ x); }
    unsigned voff[2][4];
    { const unsigned q4 = ((unsigned)lane & 15u) >> 2, p = (unsigned)lane & 3u, blk16 = ((unsigned)lane >> 4) & 1u;
#pragma unroll
      for (int t = 0; t < 2; ++t)
#pragma unroll
          for (int c = 0; c < 4; ++c) voff[t][c] = 256u * (4u * (unsigned)hi + q4) + 16u * ((4u * (unsigned)c + 2u * blk16 + (p >> 1)) ^ ((q4 << 2) | ((2u * (unsigned)t + (unsigned)hi) & 3u))) + 8u * (p & 1u); }
    float cvec[16];
#pragma unroll
    for (int r = 0; r < 16; ++r) cvec[r] = slope2 * (float)((r & 3) + 8 * (r >> 2));
    f32x16 O[4];
#pragma unroll
    for (int c = 0; c < 4; ++c)
#pragma unroll
        for (int r = 0; r < 16; ++r) O[c][r] = 0.f;
    float mref = -INFINITY, lsum = 0.f;
    AT_STORET(0);
    __syncthreads();
    for (int j = 0; j < NT; ++j) {
        const int buf = j & 1;
        if (j + 1 < NT) AT_LOADT(j + 1);
        if (64 * j <= qp_max) {
            const float tl = slope2 * (float)(64 * j + 4 * hi - qp);
            f32x16 s0, s1;
#pragma unroll
            for (int r = 0; r < 16; ++r) { s0[r] = tl + cvec[r]; s1[r] = s0[r] + 32.0f * slope2; }
            AT_LAS const unsigned char* kb = lds + buf * 16384;
#pragma unroll
            for (int d0 = 0; d0 < 4; ++d0) {
                const bf16x8 k0 = *(AT_LAS const bf16x8*)(kb + koff[d0]);
                const bf16x8 k1 = *(AT_LAS const bf16x8*)(kb + 8192 + koff[d0]);
                s0 = AT_MFMA(k0, qf[d0], s0); s1 = AT_MFMA(k1, qf[d0], s1);
            }
            if (64 * j + 63 > qp_min) {
#pragma unroll
                for (int r = 0; r < 16; ++r) { const int kp = 64 * j + crow(r, hi); if (kp > qp) s0[r] = -INFINITY; if (kp + 32 > qp) s1[r] = -INFINITY; }
            }
            float mt = fmaxf(s0[0], s1[0]);
#pragma unroll
            for (int r = 1; r < 16; ++r) mt = fmaxf(mt, fmaxf(s0[r], s1[r]));
            mt = swap_max(mt);
            if (__any(mt > mref + THR)) {
                const float mnew = fmaxf(mref, mt);
                const float alpha = __builtin_amdgcn_exp2f(mref - mnew);
                lsum *= alpha;
#pragma unroll
                for (int c = 0; c < 4; ++c)
#pragma unroll
                    for (int r = 0; r < 16; ++r) O[c][r] *= alpha;
                mref = mnew;
            }
            float ps = 0.f;
#pragma unroll
            for (int r = 0; r < 16; ++r) { s0[r] = __builtin_amdgcn_exp2f(s0[r] - mref); s1[r] = __builtin_amdgcn_exp2f(s1[r] - mref); ps += s0[r] + s1[r]; }
            lsum += ps;
            bf16x8 pf[4];
#pragma unroll
            for (int s = 0; s < 4; ++s) { u32x4 w;
                if (s < 2) { w.x = cvtpk(s0[8 * s + 0], s0[8 * s + 1]); w.y = cvtpk(s0[8 * s + 2], s0[8 * s + 3]); w.z = cvtpk(s0[8 * s + 4], s0[8 * s + 5]); w.w = cvtpk(s0[8 * s + 6], s0[8 * s + 7]); }
                else { w.x = cvtpk(s1[8 * s - 16], s1[8 * s - 15]); w.y = cvtpk(s1[8 * s - 14], s1[8 * s - 13]); w.z = cvtpk(s1[8 * s - 12], s1[8 * s - 11]); w.w = cvtpk(s1[8 * s - 10], s1[8 * s - 9]); }
                pf[s] = __builtin_bit_cast(bf16x8, w); }
            AT_LAS const unsigned char* vb = lds + 32768 + buf * 16384;
#pragma unroll
            for (int s = 0; s < 4; ++s)
#pragma unroll
                for (int c = 0; c < 4; ++c) {
                    const s16x4 lo = vtr(vb + (s >> 1) * 8192 + (s & 1) * 4096 + voff[0][c]);
                    const s16x4 hh = vtr(vb + (s >> 1) * 8192 + (s & 1) * 4096 + 2048 + voff[1][c]);
                    const bf16x8 vf = __builtin_shufflevector(lo, hh, 0, 1, 2, 3, 4, 5, 6, 7);
                    O[c] = AT_MFMA(vf, pf[s], O[c]);
                }
        }
        if (j + 1 < NT) AT_STORET(buf ^ 1);
        __syncthreads();
    }
    lsum = swap_add(lsum);
    const float inv = 1.0f / lsum;
    AT_LAS f32x4* xch = (AT_LAS f32x4*)(lds + qblk * 16384) + lane;
    if (map == 1) {
#pragma unroll
        for (int c = 0; c < 4; ++c)
#pragma unroll
            for (int g = 0; g < 4; ++g) xch[(c * 4 + g) * 64] = (f32x4){O[c][4 * g] * inv, O[c][4 * g + 1] * inv, O[c][4 * g + 2] * inv, O[c][4 * g + 3] * inv};
    }
    __syncthreads();
    if (map == 0) {
        float ms = 0.f;
#pragma unroll
        for (int c = 0; c < 4; ++c)
#pragma unroll
            for (int g = 0; g < 4; ++g) { const f32x4 o2 = xch[(c * 4 + g) * 64];
#pragma unroll
                for (int e = 0; e < 4; ++e) { const float o = O[c][4 * g + e] * inv - lam * o2[e]; O[c][4 * g + e] = o; ms += o * o; } }
        ms = swap_add(ms);
        const float rn = __builtin_amdgcn_rsqf(ms * (1.0f / 128.0f) + 1e-5f) * 0.8f;
        bf16_t* orow = cat + (size_t)qrow_g * 2048 + h * 128 + 4 * hi;
#pragma unroll
        for (int c = 0; c < 4; ++c)
#pragma unroll
            for (int g = 0; g < 4; ++g) { const f32x4 hg = *(const f32x4*)(head_g + 32 * c + 8 * g + 4 * hi);
                u32x2 w; w.x = cvtpk(O[c][4 * g] * rn * hg[0], O[c][4 * g + 1] * rn * hg[1]); w.y = cvtpk(O[c][4 * g + 2] * rn * hg[2], O[c][4 * g + 3] * rn * hg[3]);
                *(u32x2*)(orow + 32 * c + 8 * g) = w; }
    }
    __syncthreads();
#undef AT_LOADT
#undef AT_STORET
}
}

namespace cg = cooperative_groups;
#define GAS __attribute__((address_space(1)))
#define LAS __attribute__((address_space(3)))
typedef unsigned short bf16;
typedef unsigned v4u __attribute__((ext_vector_type(4)));
typedef unsigned v2u __attribute__((ext_vector_type(2)));
typedef float f32x4 __attribute__((ext_vector_type(4)));
constexpr int NWAVES = 8;
#ifndef DUP_SYNC
#define DUP_SYNC 0
#endif
#define GSYNC() do { grid.sync(); if (DUP_SYNC) grid.sync(); } while (0)
#define XSYNC() do { xcd_barrier(xbar); if (DUP_SYNC) xcd_barrier(xbar); } while (0)
#ifndef DUP_P0
#define DUP_P0 0
#endif
#ifndef DUP_P1
#define DUP_P1 0
#endif
#ifndef DUP_P2
#define DUP_P2 0
#endif
#ifndef DUP_P4
#define DUP_P4 0
#endif
constexpr int BATCH = 8, SEQ = 2048, DM = 2048, M = BATCH * SEQ, NMETA = 16, INW = 6144, DFF = 5632, NGU = 2 * DFF;
constexpr float NORM_EPS = 1e-6f;
constexpr float C2 = 0.125f * 1.4426950408889634f;
constexpr size_t MiB = 1u << 20;
constexpr size_t WS_CTL = 0, CTL_ZERO_BYTES = 1 * MiB;
constexpr size_t WS_BAR = 256 * 1024;
constexpr size_t WS_METAP = 1 * MiB;
constexpr size_t WS_MPART = 2 * MiB;
constexpr size_t WS_WIN = 6 * MiB, WS_WOUT = 30 * MiB, WS_WGU = 38 * MiB, WS_WDN = 82 * MiB;
constexpr size_t WS_A = 104 * MiB;
constexpr size_t WS_PROJ = 168 * MiB;
constexpr size_t WS_CAT = 360 * MiB, WS_END = 424 * MiB;
constexpr int LDS_BYTES = 147456;
constexpr int MP_KC = 8, MP_COLS = 5120;

__device__ __forceinline__ float wave_sum(float v) {
#pragma unroll
    for (int o = 1; o < 64; o <<= 1) v += __shfl_xor(v, o);
    return v;
}
__device__ __forceinline__ float bf2f(unsigned short h) { return __uint_as_float(((unsigned)h) << 16); }
#define LDS_WAIT() asm volatile("s_waitcnt lgkmcnt(0)" ::: "memory")

__device__ __forceinline__ void tr_item(const float* __restrict__ W, int N, int k0, int n0, const float* __restrict__ kscale, bf16* __restrict__ out, int out_ld, int out_row0, LAS float* scr, int lane) {
#pragma unroll 16
    for (int i = 0; i < 64; ++i) { float v = W[(size_t)(k0 + i) * N + n0 + lane]; if (kscale) v *= kscale[k0 + i]; scr[i * 65 + lane] = v; }
    LDS_WAIT(); asm volatile("" ::: "memory");
    const int c = lane & 7;
#pragma unroll
    for (int j = 0; j < 8; ++j) { const int n = (lane >> 3) + 8 * j; const LAS float* s = scr + (8 * c) * 65 + n;
        v4u o; o.x = pg8::cvt_pk_bf16(s[0 * 65], s[1 * 65]); o.y = pg8::cvt_pk_bf16(s[2 * 65], s[3 * 65]); o.z = pg8::cvt_pk_bf16(s[4 * 65], s[5 * 65]); o.w = pg8::cvt_pk_bf16(s[6 * 65], s[7 * 65]);
        *(v4u*)(out + (size_t)(out_row0 + n) * out_ld + k0 + 8 * c) = o; }
    LDS_WAIT(); asm volatile("" ::: "memory");
}

#define XB_TMO      128
#define XB_XCNT(j)  (256  + 64 * (j))
#define XB_XSUB(j)  (1280 + 64 * (j))
#define XB_XGEN(j)  (2304 + 64 * (j))
#define XB_TOP      3328
#define XB_TOPGEN   3392
#define XCD_BAR_WORDS 3456
#define XB_SPIN_CAP (1u << 18)

__device__ __forceinline__ unsigned xb_ld(unsigned* p)              { return __hip_atomic_load(p, __ATOMIC_RELAXED, __HIP_MEMORY_SCOPE_AGENT); }
__device__ __forceinline__ unsigned xb_add(unsigned* p, unsigned v) { return __hip_atomic_fetch_add(p, v, __ATOMIC_RELAXED, __HIP_MEMORY_SCOPE_AGENT); }
__device__ __forceinline__ unsigned xb_xcc_id() { return (unsigned)__builtin_amdgcn_s_getreg((3 << 11) | 20) & 0xFu; }
#define XB_SPIN(cond, bar) do { unsigned _sp = 0; while (cond) { __builtin_amdgcn_s_sleep(1); \
    if ((++_sp & 255u) == 0u) { if (xb_ld(&(bar)[XB_TMO])) break; if (_sp > XB_SPIN_CAP) { atomicAdd(&(bar)[XB_TMO], 1u); break; } } } } while (0)

struct XcdBarrier {
    unsigned* bar; unsigned x;
    volatile LAS unsigned* st;
};

__device__ __forceinline__ XcdBarrier xcd_barrier_post(unsigned* bar, volatile LAS unsigned* st) {
    XcdBarrier b; b.bar = bar; b.x = xb_xcc_id(); b.st = st;
    if (threadIdx.x == 0) (void)xb_add(&bar[XB_XCNT(b.x)], 1u);
    return b;
}
__device__ __forceinline__ void xcd_barrier_complete(unsigned* bar, unsigned x, unsigned& nloc, unsigned& nx) {
    const unsigned G = gridDim.x * gridDim.y * gridDim.z;
    unsigned sum, cnt, mine, sp = 0u;
    for (;;) {
        sum = 0u; cnt = 0u; mine = 0u;
#pragma unroll
        for (unsigned j = 0; j < 16; ++j) { const unsigned c = xb_ld(&bar[XB_XCNT(j)]); sum += c; cnt += (c > 0u) ? 1u : 0u; mine = (j == x) ? c : mine; }
        if (sum == G) break;
        __builtin_amdgcn_s_sleep(1);
        if ((++sp & 255u) == 0u) { if (xb_ld(&bar[XB_TMO])) break; if (sp > XB_SPIN_CAP) { atomicAdd(&bar[XB_TMO], 1u); break; } }
    }
    nloc = mine > 0u ? mine : 1u; nx = cnt > 0u ? cnt : 1u;
}

__device__ __forceinline__ void xcd_barrier(const XcdBarrier& b) {
    asm volatile("s_waitcnt vmcnt(0)" ::: "memory");
    __syncthreads();
    if (threadIdx.x == 0) {
        unsigned* bar = b.bar;
        __builtin_amdgcn_s_waitcnt(0);
        unsigned nloc = b.st[0], nx = b.st[1];
        if (nloc == 0u) { xcd_barrier_complete(bar, b.x, nloc, nx); b.st[0] = nloc; b.st[1] = nx; }
        const unsigned old = xb_add(&bar[XB_XSUB(b.x)], 1u);
        const unsigned gen = old / nloc;
        if (old + 1u == (gen + 1u) * nloc) {
            __builtin_amdgcn_fence(__ATOMIC_RELEASE, "agent");
            asm volatile("s_waitcnt vmcnt(0)" ::: "memory");
            const unsigned og = xb_add(&bar[XB_TOP], 1u);
            const unsigned tg = og / nx;
            if (og + 1u == (tg + 1u) * nx) xb_add(&bar[XB_TOPGEN], 1u);
            else XB_SPIN(xb_ld(&bar[XB_TOPGEN]) == tg, bar);
            __builtin_amdgcn_fence(__ATOMIC_ACQUIRE, "agent");
            xb_add(&bar[XB_XGEN(b.x)], 1u);
            asm volatile("s_waitcnt vmcnt(0)" ::: "memory");
        } else {
            XB_SPIN(xb_ld(&bar[XB_XGEN(b.x)]) == gen, bar);
            __builtin_amdgcn_fence(__ATOMIC_ACQUIRE, "agent");
            asm volatile("s_waitcnt vmcnt(0)" ::: "memory");
        }
    }
    __syncthreads();
}

struct Args { const float* in[16]; float* out; unsigned char* ws; };

__global__ void __launch_bounds__(NWAVES * 64, 2) hymba_fwd(Args args) {
    extern __shared__ __attribute__((aligned(16))) unsigned char lds_raw[];
    cg::grid_group grid = cg::this_grid();
    LAS unsigned char* lds = (LAS unsigned char*)lds_raw;
    const int tid = threadIdx.x, lane = tid & 63, wave = __builtin_amdgcn_readfirstlane(tid >> 6);
    const int G = gridDim.x, bx = blockIdx.x;
    const int vcu = (G % 8 == 0) ? (bx % 8) * (G / 8) + bx / 8 : bx;
    const int gw = __builtin_amdgcn_readfirstlane(vcu * NWAVES + wave), NGW = G * NWAVES;
    volatile LAS unsigned* bar_st = (volatile LAS unsigned*)(lds + 139264);
    if (tid < 2) bar_st[tid] = 0u;
    __syncthreads();
    const XcdBarrier xbar = xcd_barrier_post((unsigned*)(args.ws + WS_BAR), bar_st);
#define WSP (args.ws)
#define XIN (args.in[0])
#define meta (args.in[1])
#define g1 (args.in[2])
#define w_in (args.in[3])
#define head_g (args.in[8])
#define conv_w (args.in[9])
#define w_out (args.in[10])
#define g2 (args.in[11])
#define w_gate (args.in[12])
#define w_up (args.in[13])
#define w_down (args.in[14])
#define gf (args.in[15])
#define OUTP (args.out)
#define ssq1 ((float*)(WSP + WS_CTL))
#define ssq2 (((float*)(WSP + WS_CTL)) + M)
#define metap ((bf16*)(WSP + WS_METAP))
#define mpart ((float*)(WSP + WS_MPART))
#define Win_t ((bf16*)(WSP + WS_WIN))
#define Wout_t ((bf16*)(WSP + WS_WOUT))
#define Wgu_t ((bf16*)(WSP + WS_WGU))
#define Wdn_t ((bf16*)(WSP + WS_WDN))
#define Abuf ((bf16*)(WSP + WS_A))
#define proj ((bf16*)(WSP + WS_PROJ))
#define act ((bf16*)(WSP + WS_PROJ))
#define cat ((bf16*)(WSP + WS_CAT))
    {
        for (int task_ = gw; task_ < 80 * MP_KC * (1 + DUP_P0); task_ += NGW) { const int task = task_ % (80 * MP_KC);
            const int cc = task % 80, kc = task / 80; const int col = 1024 + cc * 64 + lane;
            float acc[16];
#pragma unroll
            for (int r = 0; r < 16; ++r) acc[r] = 0.f;
#pragma unroll 4
            for (int k = kc * 256; k < kc * 256 + 256; ++k) { const float w = w_in[(size_t)k * INW + col] * g1[k];
#pragma unroll
                for (int r = 0; r < 16; ++r) acc[r] = fmaf(meta[r * DM + k], w, acc[r]); }
#pragma unroll
            for (int r = 0; r < 16; ++r) mpart[(size_t)(kc * 16 + r) * MP_COLS + cc * 64 + lane] = acc[r];
        }
        LAS float* scr = (LAS float*)(lds + wave * 16640);
        constexpr int I_IN = 32 * 96, I_OUT = 32 * 32, I_G = 32 * 88, I_D = 88 * 32, NITEMS = I_IN + I_OUT + 2 * I_G + I_D;
        for (int it = gw; it < NITEMS * (1 + DUP_P0); it += NGW) {
            int r = it % NITEMS;
            if (r < I_IN) { tr_item(w_in, INW, 64 * (r / 96), 64 * (r % 96), nullptr, Win_t, DM, 64 * (r % 96), scr, lane); continue; } r -= I_IN;
            if (r < I_OUT) { tr_item(w_out, DM, 64 * (r / 32), 64 * (r % 32), nullptr, Wout_t, DM, 64 * (r % 32), scr, lane); continue; } r -= I_OUT;
            if (r < I_G) { const int n0 = 64 * (r % 88); tr_item(w_gate, DFF, 64 * (r / 88), n0, g2, Wgu_t, DM, 256 * (n0 / 128) + (n0 % 128), scr, lane); continue; } r -= I_G;
            if (r < I_G) { const int n0 = 64 * (r % 88); tr_item(w_up, DFF, 64 * (r / 88), n0, g2, Wgu_t, DM, 256 * (n0 / 128) + 128 + (n0 % 128), scr, lane); continue; } r -= I_G;
            tr_item(w_down, DM, 64 * (r / 32), 64 * (r % 32), nullptr, Wdn_t, DFF, 64 * (r % 32), scr, lane);
        }
        for (int m_ = gw; m_ < M * (1 + DUP_P0); m_ += NGW) { const int m = m_ % M;
            const f32x4* xr = (const f32x4*)(XIN + (size_t)m * DM) + lane; f32x4 v[8]; float s = 0.f;
#pragma unroll
            for (int j = 0; j < 8; ++j) { v[j] = xr[64 * j]; s += (v[j].x * v[j].x + v[j].y * v[j].y) + (v[j].z * v[j].z + v[j].w * v[j].w); }
            const float rs = __builtin_amdgcn_rsqf(wave_sum(s) * (1.0f / DM) + NORM_EPS);
            v2u* o8 = (v2u*)(Abuf + (size_t)m * DM) + lane;
#pragma unroll
            for (int j = 0; j < 8; ++j) { const f32x4 g = ((const f32x4*)g1)[64 * j + lane]; v2u w; w.x = pg8::cvt_pk_bf16(v[j].x * rs * g.x, v[j].y * rs * g.y); w.y = pg8::cvt_pk_bf16(v[j].z * rs * g.z, v[j].w * rs * g.w); o8[64 * j] = w; }
        }
    }
    GSYNC();

    if (bx < 16) {
        const int r = bx; float s = 0.f;
        for (int k = lane; k < DM; k += 64) { const float v = meta[r * DM + k]; s += v * v; }
        const float rs = __builtin_amdgcn_rsqf(wave_sum(s) * (1.0f / DM) + NORM_EPS);
        for (int c = tid; c < MP_COLS; c += NWAVES * 64) { float a = 0.f;
#pragma unroll
            for (int kc = 0; kc < MP_KC; ++kc) a += mpart[(size_t)(kc * 16 + r) * MP_COLS + c];
            metap[(size_t)r * INW + 1024 + c] = (bf16)(pg8::cvt_pk_bf16(a * rs, 0.f) & 0xffffu); }
    }
    {
        pg8::Gemm g{Abuf, Win_t, M, INW, DM}; pg8::StaticOrder S; S.init(M, INW, G, bx); S.reps = 1 + DUP_P1;
        pg8::EpiProj E{proj, C2};
        pg8::gemm_phase<pg8::EpiProj, pg8::StaticOrder, true, true>(lds, g, S, E);
    }
    XSYNC();

    {
        float lam;
        { const float a = args.in[4][lane] * args.in[5][lane], c = args.in[6][lane] * args.in[7][lane];
          lam = __expf(wave_sum(a)) - __expf(wave_sum(c)) + 0.2f; }
        for (int pi_ = vcu; pi_ < 512 * (1 + DUP_P2); pi_ += G) { const int pi = pi_ & 511;
            const int bh = pi >> 3, s = pi & 7;
            at::attn_unit(lds, proj, metap, cat, head_g, bh >> 3, bh & 7, 15 - s, lam);
            at::attn_unit(lds, proj, metap, cat, head_g, bh >> 3, bh & 7, s, lam);
        }
        for (int idx_ = vcu * (NWAVES * 64) + tid; idx_ < M * 128 * (1 + DUP_P2); idx_ += G * NWAVES * 64) { const int idx = idx_ % (M * 128);
            const int row = idx >> 7, c8 = (idx & 127) * 8, s = row & (SEQ - 1);
            const bf16* r0 = proj + (size_t)row * INW;
            const bf16* r1 = s >= 1 ? r0 - INW : metap + (size_t)15 * INW;
            const bf16* r2 = s >= 2 ? r0 - 2 * INW : metap + (size_t)(14 + s) * INW;
            const v4u bgv = *(const v4u*)(r0 + 3072 + c8), c0v = *(const v4u*)(r0 + 4096 + c8), h0v = *(const v4u*)(r0 + 5120 + c8);
            const v4u c1v = *(const v4u*)(r1 + 4096 + c8), h1v = *(const v4u*)(r1 + 5120 + c8), c2v = *(const v4u*)(r2 + 4096 + c8), h2v = *(const v4u*)(r2 + 5120 + c8);
            float y[8];
#pragma unroll
            for (int e = 0; e < 8; ++e) {
                const int w = e >> 1, sh = (e & 1) * 16;
                const float bg = __uint_as_float((bgv[w] >> sh) << 16), u0 = __uint_as_float((c0v[w] >> sh) << 16) * __uint_as_float((h0v[w] >> sh) << 16);
                const float u1 = __uint_as_float((c1v[w] >> sh) << 16) * __uint_as_float((h1v[w] >> sh) << 16), u2 = __uint_as_float((c2v[w] >> sh) << 16) * __uint_as_float((h2v[w] >> sh) << 16);
                y[e] = bg * (conv_w[c8 + e] * u2 + conv_w[1024 + c8 + e] * u1 + conv_w[2048 + c8 + e] * u0);
            }
            v4u o; o.x = pg8::cvt_pk_bf16(y[0], y[1]); o.y = pg8::cvt_pk_bf16(y[2], y[3]); o.z = pg8::cvt_pk_bf16(y[4], y[5]); o.w = pg8::cvt_pk_bf16(y[6], y[7]);
            *(v4u*)(cat + (size_t)row * DM + 1024 + c8) = o;
        }
    }
    XSYNC();

    {
        pg8::Gemm g{cat, Wout_t, M, DM, DM}; pg8::StaticOrder S; S.init(M, DM, G, bx);
        pg8::EpiRes1 E{XIN, Abuf, ssq1};
        pg8::gemm_phase<pg8::EpiRes1, pg8::StaticOrder, true, true>(lds, g, S, E);
    }
    XSYNC();

    {
        pg8::Gemm g{Abuf, Wgu_t, M, NGU, DM}; pg8::StaticOrder S; S.init(M, NGU, G, bx); S.reps = 1 + DUP_P4;
        pg8::EpiGU E{act, ssq1};
        pg8::gemm_phase<pg8::EpiGU, pg8::StaticOrder, true, true>(lds, g, S, E);
    }
    XSYNC();

    {
        pg8::Gemm g{act, Wdn_t, M, DM, DFF}; pg8::StaticOrder S; S.init(M, DM, G, bx);
        pg8::EpiRes2 E{Abuf, cat, ssq2};
        pg8::gemm_phase<pg8::EpiRes2, pg8::StaticOrder, true, true>(lds, g, S, E);
    }
    XSYNC();

    for (int m = gw; m < M; m += NGW) {
        const float rs = __builtin_amdgcn_rsqf(ssq2[m] * (1.0f / DM) + NORM_EPS);
        const v4u* hr = (const v4u*)(cat + (size_t)m * DM) + lane;
        f32x4* o = (f32x4*)(OUTP + (size_t)m * DM);
        v4u hv[4];
#pragma unroll
        for (int j = 0; j < 4; ++j) hv[j] = hr[64 * j];
#pragma unroll
        for (int j = 0; j < 4; ++j) { const int c8 = (64 * j + lane) * 2; const f32x4 ga = ((const f32x4*)gf)[c8], gb = ((const f32x4*)gf)[c8 + 1];
            f32x4 va, vb; va.x = pg8::bflo(hv[j].x) * rs * ga.x; va.y = pg8::bfhi(hv[j].x) * rs * ga.y; va.z = pg8::bflo(hv[j].y) * rs * ga.z; va.w = pg8::bfhi(hv[j].y) * rs * ga.w;
            vb.x = pg8::bflo(hv[j].z) * rs * gb.x; vb.y = pg8::bfhi(hv[j].z) * rs * gb.y; vb.z = pg8::bflo(hv[j].w) * rs * gb.z; vb.w = pg8::bfhi(hv[j].w) * rs * gb.w;
            __builtin_nontemporal_store(va, o + c8); __builtin_nontemporal_store(vb, o + c8 + 1); }
    }
}

#undef WSP
#undef XIN
#undef meta
#undef g1
#undef w_in
#undef head_g
#undef conv_w
#undef w_out
#undef g2
#undef w_gate
#undef w_up
#undef w_down
#undef gf
#undef OUTP
#undef ssq1
#undef ssq2
#undef metap
#undef mpart
#undef Win_t
#undef Wout_t
#undef Wgu_t
#undef Wdn_t
#undef Abuf
#undef proj
#undef act
#undef cat

extern "C" void kernel_launch(void* const* d_in, const int* in_sizes, int n_in, void* d_out, int out_size, void* d_ws, size_t ws_size, hipStream_t stream) {
    static int grid_blocks = 0;
    if (grid_blocks == 0) {
        if (n_in != 16 || in_sizes[0] != M * DM || out_size != M * DM || ws_size < WS_END) { fprintf(stderr, "kernel_launch: unexpected shapes (n_in %d, in0 %d, out %d, ws %zu)\n", n_in, n_in > 0 ? in_sizes[0] : -1, out_size, ws_size); grid_blocks = -1; return; }
        int dev = 0, cus = 0, per_cu = 0;
        (void)hipGetDevice(&dev); (void)hipDeviceGetAttribute(&cus, hipDeviceAttributeMultiprocessorCount, dev);
        if (hipFuncSetAttribute((const void*)hymba_fwd, hipFuncAttributeMaxDynamicSharedMemorySize, LDS_BYTES) != hipSuccess) fprintf(stderr, "kernel_launch: hipFuncSetAttribute failed\n");
        if (hipOccupancyMaxActiveBlocksPerMultiprocessor(&per_cu, (const void*)hymba_fwd, NWAVES * 64, LDS_BYTES) != hipSuccess || per_cu < 1) { fprintf(stderr, "kernel_launch: occupancy query gave %d\n", per_cu); per_cu = 1; }
        (void)hipGetLastError();
        grid_blocks = cus * per_cu;
    }
    if (grid_blocks < 0) return;
    (void)hipMemsetAsync((char*)d_ws + WS_CTL, 0, CTL_ZERO_BYTES, stream);
    Args a{};
    for (int i = 0; i < 16; ++i) a.in[i] = (const float*)d_in[i];
    a.out = (float*)d_out; a.ws = (unsigned char*)d_ws;
    void* kargs[] = {&a};
    hipError_t e = hipLaunchCooperativeKernel((const void*)hymba_fwd, dim3(grid_blocks), dim3(NWAVES * 64), kargs, LDS_BYTES, stream);
    if (e != hipSuccess) fprintf(stderr, "cooperative launch failed: %s (grid %d)\n", hipGetErrorString(e), grid_blocks);
}
```

```cpp
#include <hip/hip_runtime.h>
#include <hip/hip_cooperative_groups.h>
#include <cstdio>
#include <cstdint>
#include <cmath>
namespace pg8 {
#define PG8_LAS __attribute__((address_space(3)))
typedef unsigned short bf16_t;
typedef short bf16x8 __attribute__((ext_vector_type(8)));
typedef float f32x4 __attribute__((ext_vector_type(4)));
typedef unsigned u32x4 __attribute__((ext_vector_type(4)));
constexpr int BM = 256, BK = 64, HALF = 128, HTB = HALF * BK * 2  , STAGE_BYTES = 8 * HTB, NXCD = 8, WGM = 8;

__host__ __device__ __forceinline__ int lds_byte(int r, int c) { const int st = (r >> 4) * 2 + (c >> 5), rr = r & 15, cc = c & 31, ob = rr * 64 + cc * 2; return st * 1024 + (ob ^ (((ob >> 9) & 1) << 5)); }
__host__ __device__ __forceinline__ void stage_rc(int b, int& R, int& C) { const int st = b / 1024, sb = b % 1024, swz = sb ^ (((sb >> 9) & 1) << 5); R = (st >> 1) * 16 + swz / 64; C = (st & 1) * 32 + (swz % 64) / 2; }
__host__ __device__ __forceinline__ int perm32(int rho) { const int n = rho >> 4, i = rho & 15; return 8 * (i >> 2) + 4 * n + (i & 3); }

struct Unit { int pm, pn, last; };
struct Gemm { const bf16_t* A; const bf16_t* Bt; int M, N, K; };

struct StaticOrder {
    int nM, nN, nwg, G, c, reps = 1;
    __host__ __device__ void init(int M, int N, int G_, int c_) { nM = M / BM; nN = N / BM; nwg = nM * nN; G = G_; c = c_; }
    __host__ __device__ bool next(int i, Unit& u) const {
        const long L = (long)i * G + c; if (L >= (long)nwg * reps) return false;
        int wgid = (int)(L % nwg); u.last = (L / nwg == reps - 1); { const int q = nwg / NXCD, r = nwg % NXCD, xcd = wgid % NXCD, off = wgid / NXCD; wgid = (xcd < r ? xcd * (q + 1) : r * (q + 1) + (xcd - r) * q) + off; }
        const int nig = WGM * nN, gid = wgid / nig, fm = gid * WGM, gsz = (nM - fm) < WGM ? (nM - fm) : WGM;
        u.pm = fm + ((wgid % nig) % gsz); u.pn = (wgid % nig) / gsz; return true;
    }
    __device__ __forceinline__ void a_ready(const Unit&) const {}
    __device__ __forceinline__ void done(const Unit&) const {}
};

__device__ __forceinline__ unsigned cvt_pk_bf16(float lo, float hi) { unsigned r; asm volatile("v_cvt_pk_bf16_f32 %0, %1, %2" : "=v"(r) : "v"(lo), "v"(hi)); return r; }
typedef float f32x2 __attribute__((ext_vector_type(2)));
struct EpiProj {
    static constexpr bool PERM = true, AFTER_DRAIN = false;
    bf16_t* O; float qscale;
    __device__ __forceinline__ void operator()(const f32x4 (&acc)[2][2][4][2], const Unit& u, int wr, int wc, int fr, int fq) const {
        const int row0 = u.pm * BM + wr * 64 + fr; const int colt = u.pn * BM;
        const float sc = (colt < 1024) ? qscale : 1.f;
        const int col0 = colt + wc * 32 + 8 * fq;
#pragma unroll
        for (int ai = 0; ai < 2; ++ai)
#pragma unroll
            for (int m = 0; m < 4; ++m) { bf16_t* rowp = O + (size_t)(row0 + ai * HALF + m * 16) * 6144 + col0;
#pragma unroll
                for (int bj = 0; bj < 2; ++bj) { const f32x4 v0 = acc[ai][bj][m][0] * sc, v1 = acc[ai][bj][m][1] * sc;
                    u32x4 w; w.x = cvt_pk_bf16(v0[0], v0[1]); w.y = cvt_pk_bf16(v0[2], v0[3]); w.z = cvt_pk_bf16(v1[0], v1[1]); w.w = cvt_pk_bf16(v1[2], v1[3]);
                    *(u32x4*)(rowp + bj * HALF) = w; } }
    }
};
struct EpiRes1 {
    static constexpr bool PERM = true, AFTER_DRAIN = false;
    const float* __restrict__ X; bf16_t* __restrict__ Hb; float* __restrict__ ssq_; int dup_off;
    __device__ __forceinline__ void operator()(const f32x4 (&acc)[2][2][4][2], const Unit& u, int wr, int wc, int fr, int fq) const {
        float* ssq = ssq_ + (u.last ? 0 : dup_off);
        const int row0 = u.pm * BM + wr * 64 + fr; const int col0 = u.pn * BM + wc * 32 + 8 * fq;
#pragma unroll
        for (int g2 = 0; g2 < 4; ++g2) { const int ai = g2 >> 1, mb = (g2 & 1) * 2;
            f32x4 pre[2][2][2];
#pragma unroll
            for (int mm = 0; mm < 2; ++mm)
#pragma unroll
                for (int bj = 0; bj < 2; ++bj) { const size_t off = (size_t)(row0 + ai * HALF + (mb + mm) * 16) * 2048 + col0 + bj * HALF;
                    pre[mm][bj][0] = __builtin_nontemporal_load((const f32x4*)(X + off)); pre[mm][bj][1] = __builtin_nontemporal_load((const f32x4*)(X + off + 4)); }
            asm volatile("" ::: "memory");
#pragma unroll
            for (int mm = 0; mm < 2; ++mm) { const int m = mb + mm; const int row = row0 + ai * HALF + m * 16; float ss = 0.f;
#pragma unroll
                for (int bj = 0; bj < 2; ++bj) { const size_t off = (size_t)row * 2048 + col0 + bj * HALF;
                    const f32x4 v0 = acc[ai][bj][m][0] + pre[mm][bj][0], v1 = acc[ai][bj][m][1] + pre[mm][bj][1];
                    u32x4 w; w.x = cvt_pk_bf16(v0[0], v0[1]); w.y = cvt_pk_bf16(v0[2], v0[3]); w.z = cvt_pk_bf16(v1[0], v1[1]); w.w = cvt_pk_bf16(v1[2], v1[3]); *(u32x4*)(Hb + off) = w;
                    ss += (v0[0] * v0[0] + v0[1] * v0[1]) + (v0[2] * v0[2] + v0[3] * v0[3]) + (v1[0] * v1[0] + v1[1] * v1[1]) + (v1[2] * v1[2] + v1[3] * v1[3]); }
                ss += __shfl_xor(ss, 16); ss += __shfl_xor(ss, 32);
                if (fq == 0) atomicAdd(ssq + row, ss); }
        }
    }
};
__device__ __forceinline__ float bflo(unsigned w) { return __uint_as_float(w << 16); }
__device__ __forceinline__ float bfhi(unsigned w) { return __uint_as_float(w & 0xffff0000u); }
struct EpiRes2 {
    static constexpr bool PERM = true, AFTER_DRAIN = false;
    const bf16_t* __restrict__ X; bf16_t* __restrict__ Hb; float* __restrict__ ssq_; int dup_off;
    __device__ __forceinline__ void operator()(const f32x4 (&acc)[2][2][4][2], const Unit& u, int wr, int wc, int fr, int fq) const {
        float* ssq = ssq_ + (u.last ? 0 : dup_off);
        const int row0 = u.pm * BM + wr * 64 + fr; const int col0 = u.pn * BM + wc * 32 + 8 * fq;
#pragma unroll
        for (int ai = 0; ai < 2; ++ai) {
            u32x4 pre[4][2];
#pragma unroll
            for (int m = 0; m < 4; ++m)
#pragma unroll
                for (int bj = 0; bj < 2; ++bj) pre[m][bj] = *(const u32x4*)(X + (size_t)(row0 + ai * HALF + m * 16) * 2048 + col0 + bj * HALF);
            asm volatile("" ::: "memory");
#pragma unroll
            for (int m = 0; m < 4; ++m) { const int row = row0 + ai * HALF + m * 16; float ss = 0.f;
#pragma unroll
                for (int bj = 0; bj < 2; ++bj) { const size_t off = (size_t)row * 2048 + col0 + bj * HALF; const u32x4 xr = pre[m][bj];
                    const f32x4 v0 = acc[ai][bj][m][0] + (f32x4){bflo(xr.x), bfhi(xr.x), bflo(xr.y), bfhi(xr.y)}, v1 = acc[ai][bj][m][1] + (f32x4){bflo(xr.z), bfhi(xr.z), bflo(xr.w), bfhi(xr.w)};
                    u32x4 w; w.x = cvt_pk_bf16(v0[0], v0[1]); w.y = cvt_pk_bf16(v0[2], v0[3]); w.z = cvt_pk_bf16(v1[0], v1[1]); w.w = cvt_pk_bf16(v1[2], v1[3]); *(u32x4*)(Hb + off) = w;
                    ss += (v0[0] * v0[0] + v0[1] * v0[1]) + (v0[2] * v0[2] + v0[3] * v0[3]) + (v1[0] * v1[0] + v1[1] * v1[1]) + (v1[2] * v1[2] + v1[3] * v1[3]); }
                ss += __shfl_xor(ss, 16); ss += __shfl_xor(ss, 32);
                if (fq == 0) atomicAdd(ssq + row, ss); }
        }
    }
};
struct EpiGU {
    static constexpr bool PERM = true, AFTER_DRAIN = false;
    bf16_t* O; const float* ssq;
    __device__ __forceinline__ void operator()(const f32x4 (&acc)[2][2][4][2], const Unit& u, int wr, int wc, int fr, int fq) const {
        const int row0 = u.pm * BM + wr * 64 + fr; const int col0 = u.pn * HALF + wc * 32 + 8 * fq;
#pragma unroll
        for (int ai = 0; ai < 2; ++ai)
#pragma unroll
            for (int m = 0; m < 4; ++m) { const int row = row0 + ai * HALF + m * 16;
                const float rs = __builtin_amdgcn_rsqf(ssq[row] * (1.0f / 2048.0f) + 1e-6f);
                float a[8];
#pragma unroll
                for (int n = 0; n < 2; ++n)
#pragma unroll
                    for (int e = 0; e < 4; ++e) { const float g = acc[ai][0][m][n][e] * rs, up = acc[ai][1][m][n][e] * rs;
                        a[n * 4 + e] = g * __builtin_amdgcn_rcpf(1.0f + __builtin_amdgcn_exp2f(-1.4426950408889634f * g)) * up; }
                u32x4 w; w.x = cvt_pk_bf16(a[0], a[1]); w.y = cvt_pk_bf16(a[2], a[3]); w.z = cvt_pk_bf16(a[4], a[5]); w.w = cvt_pk_bf16(a[6], a[7]);
                *(u32x4*)(O + (size_t)row * 5632 + col0) = w; }
    }
};
template <class Epi, class Sched, bool ALIGN_EPI = false, bool SP2 = false>
__device__ __forceinline__ void gemm_phase(PG8_LAS unsigned char* lds, const Gemm g, const Sched& S, const Epi& E) {
    const int tid = threadIdx.x, wid = __builtin_amdgcn_readfirstlane(tid >> 6), lane = tid & 63, wr = wid >> 2, wc = wid & 3, fr = lane & 15, fq = lane >> 4;
    const int K = g.K, nt = K / BK;
    unsigned voffA[2], voffB[2];
#pragma unroll
    for (int i = 0; i < 2; ++i) { int R, C; stage_rc(tid * 16 + i * 8192, R, C); const int Rb = Epi::PERM ? ((R & ~31) + perm32(R & 31)) : R;
        voffA[i] = (unsigned)(R * K + C) * 2u; voffB[i] = (unsigned)(Rb * K + C) * 2u; }
    const size_t kstep = (size_t)(BK * 2);
    const size_t hstep = (size_t)HALF * K * 2;
    const size_t tstep = 2 * hstep;
    const unsigned ldsw = (unsigned)wid * 1024u;
    const int aoff = lds_byte(wr * 64 + fr, fq * 8), boff = lds_byte(wc * 32 + fr, fq * 8);
#define PG8_SA(b, h) (((b) * 2 + (h)) * HTB)
#define PG8_SB(b, h) ((4 + (b) * 2 + (h)) * HTB)
#define PG8_STAGE(bufoff, gbase, voff) do { _Pragma("unroll") for (int _i = 0; _i < 2; ++_i) \
        __builtin_amdgcn_global_load_lds((const unsigned*)((const char*)(gbase) + (voff)[_i]), (PG8_LAS unsigned*)(lds + (bufoff) + ldsw + _i * 8192), 16, 0, 0); } while (0)
#define PG8_LDA(dst, b, h) do { _Pragma("unroll") for (int m = 0; m < 4; ++m) _Pragma("unroll") for (int k = 0; k < 2; ++k) dst[m][k] = *(const PG8_LAS bf16x8*)(lds + PG8_SA(b, h) + aoff + m * 2048 + k * 1024); } while (0)
#define PG8_LDB(dst, b, h) do { _Pragma("unroll") for (int n = 0; n < 2; ++n) _Pragma("unroll") for (int k = 0; k < 2; ++k) dst[n][k] = *(const PG8_LAS bf16x8*)(lds + PG8_SB(b, h) + boff + n * 2048 + k * 1024); } while (0)
#define PG8_MMA(ai, bj, At, Bt) do { __builtin_amdgcn_s_setprio(1); _Pragma("unroll") for (int m = 0; m < 4; ++m) _Pragma("unroll") for (int n = 0; n < 2; ++n) _Pragma("unroll") for (int k = 0; k < 2; ++k) \
        acc[ai][bj][m][n] = __builtin_amdgcn_mfma_f32_16x16x32_bf16(Bt[n][k], At[m][k], acc[ai][bj][m][n], 0, 0, 0); __builtin_amdgcn_s_setprio(0); } while (0)
#define PG8_WAIT_V(n) asm volatile("s_waitcnt vmcnt(" #n ")" ::: "memory")
#define PG8_WAIT_L(n) asm volatile("s_waitcnt lgkmcnt(" #n ")" ::: "memory")
#define PG8_BAR __builtin_amdgcn_s_barrier()
#define PG8_SCHED __builtin_amdgcn_sched_barrier(0)
    Unit cur, nxt; int ui = 0;
    if (!S.next(0, cur)) return;
    f32x4 acc[2][2][4][2];
#pragma unroll
    for (int a = 0; a < 2; ++a)
#pragma unroll
        for (int b = 0; b < 2; ++b)
#pragma unroll
            for (int m = 0; m < 4; ++m)
#pragma unroll
                for (int n = 0; n < 2; ++n) acc[a][b][m][n] = (f32x4){0.f, 0.f, 0.f, 0.f};
    bf16x8 At[4][2], B0[2][2], B1[2][2];
    const char* cA = (const char*)g.A + (size_t)cur.pm * tstep; const char* cB = (const char*)g.Bt + (size_t)cur.pn * tstep;
    S.a_ready(cur);
    if constexpr (SP2) {
        PG8_STAGE(PG8_SB(0, 0), cB, voffB); PG8_STAGE(PG8_SB(0, 1), cB + hstep, voffB); PG8_STAGE(PG8_SA(0, 0), cA, voffA); PG8_STAGE(PG8_SA(0, 1), cA + hstep, voffA);
        if (wr == 1) PG8_BAR;
        PG8_WAIT_V(2); PG8_BAR;
        PG8_STAGE(PG8_SB(1, 0), cB + kstep, voffB); PG8_STAGE(PG8_SA(1, 0), cA + kstep, voffA); PG8_STAGE(PG8_SB(1, 1), cB + hstep + kstep, voffB);
        PG8_WAIT_V(6); PG8_BAR;
    } else {
        PG8_STAGE(PG8_SB(0, 0), cB, voffB); PG8_STAGE(PG8_SA(0, 0), cA, voffA); PG8_STAGE(PG8_SB(0, 1), cB + hstep, voffB); PG8_STAGE(PG8_SA(0, 1), cA + hstep, voffA);
        if (wr == 1) PG8_BAR;
        PG8_WAIT_V(4); PG8_BAR;
        PG8_STAGE(PG8_SB(1, 0), cB + kstep, voffB); PG8_STAGE(PG8_SA(1, 0), cA + kstep, voffA); PG8_STAGE(PG8_SB(1, 1), cB + hstep + kstep, voffB);
        PG8_WAIT_V(6); PG8_BAR;
    }
    for (;;) {
        const bool has_next = S.next(ui + 1, nxt);
        const char* nA = has_next ? (const char*)g.A + (size_t)nxt.pm * tstep : cA; const char* nB = has_next ? (const char*)g.Bt + (size_t)nxt.pn * tstep : cB;
        for (int t = 0; t < nt; t += 2) {
            const bool last = (t == nt - 2);
            const char* a1 = cA + (size_t)(t + 1) * kstep;
            const char* a2 = last ? nA : cA + (size_t)(t + 2) * kstep; const char* b2 = last ? nB : cB + (size_t)(t + 2) * kstep;
            const char* a3 = a2 + kstep; const char* b3 = b2 + kstep;
            if (last && has_next) S.a_ready(nxt);
            if constexpr (SP2) {
            PG8_LDB(B0, 0, 0); PG8_LDB(B1, 0, 1); PG8_SCHED; PG8_LDA(At, 0, 0); PG8_STAGE(PG8_SA(1, 1), a1 + hstep, voffA);
            PG8_WAIT_V(8); PG8_WAIT_L(0); PG8_BAR; PG8_MMA(0, 0, At, B0); PG8_MMA(0, 1, At, B1); PG8_BAR; PG8_SCHED;
            PG8_LDA(At, 0, 1); PG8_STAGE(PG8_SB(0, 0), b2, voffB); PG8_STAGE(PG8_SB(0, 1), b2 + hstep, voffB); PG8_STAGE(PG8_SA(0, 0), a2, voffA);
            PG8_WAIT_V(8); PG8_WAIT_L(0); PG8_BAR; PG8_MMA(1, 0, At, B0); PG8_MMA(1, 1, At, B1); PG8_BAR; PG8_SCHED;
            PG8_LDB(B0, 1, 0); PG8_LDB(B1, 1, 1); PG8_SCHED; PG8_LDA(At, 1, 0); PG8_STAGE(PG8_SA(0, 1), a2 + hstep, voffA);
            PG8_WAIT_V(8); PG8_WAIT_L(0); PG8_BAR; PG8_MMA(0, 0, At, B0); PG8_MMA(0, 1, At, B1); PG8_BAR; PG8_SCHED;
            PG8_LDA(At, 1, 1); PG8_STAGE(PG8_SB(1, 0), b3, voffB); PG8_STAGE(PG8_SB(1, 1), b3 + hstep, voffB); PG8_STAGE(PG8_SA(1, 0), a3, voffA);
            PG8_WAIT_V(8); PG8_WAIT_L(0); PG8_BAR; PG8_MMA(1, 0, At, B0); PG8_MMA(1, 1, At, B1); PG8_BAR; PG8_SCHED;
            } else {
            PG8_LDB(B0, 0, 0); PG8_SCHED; PG8_LDA(At, 0, 0); PG8_STAGE(PG8_SA(1, 1), a1 + hstep, voffA);
            PG8_WAIT_L(8); PG8_BAR; PG8_WAIT_L(0); PG8_MMA(0, 0, At, B0); PG8_BAR; PG8_SCHED;
            PG8_LDB(B1, 0, 1); PG8_STAGE(PG8_SB(0, 0), b2, voffB);
            PG8_BAR; PG8_WAIT_L(0); PG8_MMA(0, 1, At, B1); PG8_BAR;
            PG8_LDA(At, 0, 1); PG8_STAGE(PG8_SA(0, 0), a2, voffA);
            PG8_BAR; PG8_WAIT_L(0); PG8_MMA(1, 0, At, B0); PG8_BAR; PG8_SCHED;
            PG8_STAGE(PG8_SB(0, 1), b2 + hstep, voffB);
            PG8_WAIT_V(6); PG8_BAR; PG8_MMA(1, 1, At, B1); PG8_BAR;
            PG8_LDB(B0, 1, 0); PG8_SCHED; PG8_LDA(At, 1, 0); PG8_STAGE(PG8_SA(0, 1), a2 + hstep, voffA);
            PG8_WAIT_L(8); PG8_BAR; PG8_WAIT_L(0); PG8_MMA(0, 0, At, B0); PG8_BAR; PG8_SCHED;
            PG8_LDB(B1, 1, 1); PG8_STAGE(PG8_SB(1, 0), b3, voffB);
            PG8_BAR; PG8_WAIT_L(0); PG8_MMA(0, 1, At, B1); PG8_BAR;
            PG8_LDA(At, 1, 1); PG8_STAGE(PG8_SA(1, 0), a3, voffA);
            PG8_BAR; PG8_WAIT_L(0); PG8_MMA(1, 0, At, B0); PG8_BAR; PG8_SCHED;
            PG8_STAGE(PG8_SB(1, 1), b3 + hstep, voffB);
            PG8_WAIT_V(6); PG8_BAR; PG8_MMA(1, 1, At, B1); PG8_BAR;
            }
        }
        if constexpr (ALIGN_EPI) { if (wr == 0) PG8_BAR; }
        if constexpr (!Epi::AFTER_DRAIN) { E(acc, cur, wr, wc, fr, fq); S.done(cur); }
        if (!has_next) break;
#pragma unroll
        for (int a = 0; a < 2; ++a)
#pragma unroll
            for (int b = 0; b < 2; ++b)
#pragma unroll
                for (int m = 0; m < 4; ++m)
#pragma unroll
                    for (int n = 0; n < 2; ++n) acc[a][b][m][n] = (f32x4){0.f, 0.f, 0.f, 0.f};
        cur = nxt; cA = nA; cB = nB; ++ui;
        if constexpr (ALIGN_EPI) { if (wr == 1) PG8_BAR; }
    }
    PG8_WAIT_V(0);
    if constexpr (!ALIGN_EPI) { if (wr == 0) PG8_BAR; }
    PG8_BAR;
    if constexpr (Epi::AFTER_DRAIN) { E.fused(acc, cur, wr, wc, fr, fq, lds, wid, lane); S.done(cur); }
#undef PG8_SA
#undef PG8_SB
#undef PG8_STAGE
#undef PG8_LDA
#undef PG8_LDB
#undef PG8_MMA
#undef PG8_WAIT_V
#undef PG8_WAIT_L
#undef PG8_BAR
#undef PG8_SCHED
}
}

namespace at {
using pg8::bf16_t;
typedef short bf16x8 __attribute__((ext_vector_type(8)));
typedef short s16x4 __attribute__((ext_vector_type(4)));
typedef float f32x16 __attribute__((ext_vector_type(16)));
typedef float f32x4 __attribute__((ext_vector_type(4)));
typedef float f32x2_t __attribute__((ext_vector_type(2)));
typedef __bf16 bf16x2_t __attribute__((ext_vector_type(2)));
typedef unsigned u32x4 __attribute__((ext_vector_type(4)));
typedef unsigned u32x2 __attribute__((ext_vector_type(2)));
#define AT_LAS __attribute__((address_space(3)))
constexpr int PITCH = 6144, KCOL = 1024, VCOL = 2048, TLAST = 2063;
constexpr float THR = 8.0f;
__device__ __forceinline__ unsigned off_b(unsigned row, unsigned ch) { return 256u * row + 16u * (ch ^ (((row & 3u) << 2) | ((row >> 2) & 3u))); }
__device__ __forceinline__ int crow(int r, int hi) { return (r & 3) + 8 * (r >> 2) + 4 * hi; }
__device__ __forceinline__ unsigned cvtpk(float lo, float hi) { f32x2_t v = {lo, hi}; bf16x2_t b = __builtin_convertvector(v, bf16x2_t); return __builtin_bit_cast(unsigned, b); }
__device__ __forceinline__ float swap_max(float m) { auto rr = __builtin_amdgcn_permlane32_swap(__float_as_uint(m), __float_as_uint(m), false, false); return fmaxf(__uint_as_float(rr[0]), __uint_as_float(rr[1])); }
__device__ __forceinline__ float swap_add(float m) { auto rr = __builtin_amdgcn_permlane32_swap(__float_as_uint(m), __float_as_uint(m), false, false); return __uint_as_float(rr[0]) + __uint_as_float(rr[1]); }
__device__ __forceinline__ s16x4 vtr(AT_LAS const unsigned char* p) { return __builtin_bit_cast(s16x4, __builtin_amdgcn_ds_read_tr16_b64_v4i16((AT_LAS s16x4*)p)); }
#define AT_MFMA(a, b, c) __builtin_amdgcn_mfma_f32_32x32x16_bf16((a), (b), (c), 0, 0, 0)

__device__ __forceinline__ void attn_unit(AT_LAS unsigned char* lds, const bf16_t* __restrict__ proj, const bf16_t* __restrict__ metap, bf16_t* __restrict__ cat,
                                          const float* __restrict__ head_g, int b, int h, int qb, float lam) {
    const int tid = threadIdx.x, lane = tid & 63, r32 = lane & 31, hi = lane >> 5;
    const int wid = __builtin_amdgcn_readfirstlane(tid >> 6), map = wid & 1, qblk = wid >> 1;
    const int qrow_g = b * 2048 + 128 * qb + 32 * qblk + r32;
    const int qp_min = 16 + 128 * qb + 32 * qblk, qp = qp_min + r32, qp_max = qp_min + 31;
    const int NT = 2 * qb + 3;
    const float slope2 = __builtin_amdgcn_exp2f(-(float)(h + 1)) * 1.4426950408889634f;
    const int srow = tid >> 4, sch = tid & 15;
    const unsigned sdst = off_b((unsigned)srow, (unsigned)sch);
    u32x4 kreg[2], vreg[2];
#define AT_LOADT(j) do { _Pragma("unroll") for (int i_ = 0; i_ < 2; ++i_) { int p_ = 64 * (j) + srow + 32 * i_; p_ = p_ > TLAST ? TLAST : p_; \
        const bf16_t* rp_ = (p_ < 16 ? metap + (size_t)p_ * PITCH : proj + (size_t)(b * 2048 + p_ - 16) * PITCH) + h * 128 + sch * 8; \
        kreg[i_] = *(const u32x4*)(rp_ + KCOL); vreg[i_] = *(const u32x4*)(rp_ + VCOL); } } while (0)
#define AT_STORET(buf) do { _Pragma("unroll") for (int i_ = 0; i_ < 2; ++i_) { *(AT_LAS u32x4*)(lds + (buf) * 16384 + i_ * 8192 + sdst) = kreg[i_]; \
        *(AT_LAS u32x4*)(lds + 32768 + (buf) * 16384 + i_ * 8192 + sdst) = vreg[i_]; } } while (0)
    AT_LOADT(0);
    bf16x8 qf[4];
#pragma unroll
    for (int d0 = 0; d0 < 4; ++d0) qf[d0] = *(const bf16x8*)(proj + (size_t)qrow_g * PITCH + h * 128 + map * 64 + 16 * d0 + 8 * hi);
    unsigned koff[4];
    { const unsigned x = (((unsigned)lane & 3u) << 2) | (((unsigned)lane >> 2) & 3u);
#pragma unroll
      for (int d0 = 0; d0 < 4; ++d0) koff[d0] = 256u * (unsigned)r32 + 16u * (((unsigned)(8 * map + 2 * d0 + hi)) ^ x); }
    unsigned voff[2][4];
    { const unsigned q4 = ((unsigned)lane & 15u) >> 2, p = (unsigned)lane & 3u, blk16 = ((unsigned)lane >> 4) & 1u;
#pragma unroll
      for (int t = 0; t < 2; ++t)
#pragma unroll
          for (int c = 0; c < 4; ++c) voff[t][c] = 256u * (4u * (unsigned)hi + q4) + 16u * ((4u * (unsigned)c + 2u * blk16 + (p >> 1)) ^ ((q4 << 2) | ((2u * (unsigned)t + (unsigned)hi) & 3u))) + 8u * (p & 1u); }
    float cvec[16];
#pragma unroll
    for (int r = 0; r < 16; ++r) cvec[r] = slope2 * (float)((r & 3) + 8 * (r >> 2));
    f32x16 O[4];
#pragma unroll
    for (int c = 0; c < 4; ++c)
#pragma unroll
        for (int r = 0; r < 16; ++r) O[c][r] = 0.f;
    float mref = -INFINITY, lsum = 0.f;
    AT_STORET(0);
    __syncthreads();
    for (int j = 0; j < NT; ++j) {
        const int buf = j & 1;
        if (j + 1 < NT) AT_LOADT(j + 1);
        if (64 * j <= qp_max) {
            const float tl = slope2 * (float)(64 * j + 4 * hi - qp);
            f32x16 s0, s1;
#pragma unroll
            for (int r = 0; r < 16; ++r) { s0[r] = tl + cvec[r]; s1[r] = s0[r] + 32.0f * slope2; }
            AT_LAS const unsigned char* kb = lds + buf * 16384;
#pragma unroll
            for (int d0 = 0; d0 < 4; ++d0) {
                const bf16x8 k0 = *(AT_LAS const bf16x8*)(kb + koff[d0]);
                const bf16x8 k1 = *(AT_LAS const bf16x8*)(kb + 8192 + koff[d0]);
                s0 = AT_MFMA(k0, qf[d0], s0); s1 = AT_MFMA(k1, qf[d0], s1);
            }
            if (64 * j + 63 > qp_min) {
#pragma unroll
                for (int r = 0; r < 16; ++r) { const int kp = 64 * j + crow(r, hi); if (kp > qp) s0[r] = -INFINITY; if (kp + 32 > qp) s1[r] = -INFINITY; }
            }
            float mt = fmaxf(s0[0], s1[0]);
#pragma unroll
            for (int r = 1; r < 16; ++r) mt = fmaxf(mt, fmaxf(s0[r], s1[r]));
            mt = swap_max(mt);
            if (__any(mt > mref + THR)) {
                const float mnew = fmaxf(mref, mt);
                const float alpha = __builtin_amdgcn_exp2f(mref - mnew);
                lsum *= alpha;
#pragma unroll
                for (int c = 0; c < 4; ++c)
#pragma unroll
                    for (int r = 0; r < 16; ++r) O[c][r] *= alpha;
                mref = mnew;
            }
            float ps = 0.f;
#pragma unroll
            for (int r = 0; r < 16; ++r) { s0[r] = __builtin_amdgcn_exp2f(s0[r] - mref); s1[r] = __builtin_amdgcn_exp2f(s1[r] - mref); ps += s0[r] + s1[r]; }
            lsum += ps;
            bf16x8 pf[4];
#pragma unroll
            for (int s = 0; s < 4; ++s) { u32x4 w;
                if (s < 2) { w.x = cvtpk(s0[8 * s + 0], s0[8 * s + 1]); w.y = cvtpk(s0[8 * s + 2], s0[8 * s + 3]); w.z = cvtpk(s0[8 * s + 4], s0[8 * s + 5]); w.w = cvtpk(s0[8 * s + 6], s0[8 * s + 7]); }
                else { w.x = cvtpk(s1[8 * s - 16], s1[8 * s - 15]); w.y = cvtpk(s1[8 * s - 14], s1[8 * s - 13]); w.z = cvtpk(s1[8 * s - 12], s1[8 * s - 11]); w.w = cvtpk(s1[8 * s - 10], s1[8 * s - 9]); }
                pf[s] = __builtin_bit_cast(bf16x8, w); }
            AT_LAS const unsigned char* vb = lds + 32768 + buf * 16384;
#pragma unroll
            for (int s = 0; s < 4; ++s)
#pragma unroll
                for (int c = 0; c < 4; ++c) {
                    const s16x4 lo = vtr(vb + (s >> 1) * 8192 + (s & 1) * 4096 + voff[0][c]);
                    const s16x4 hh = vtr(vb + (s >> 1) * 8192 + (s & 1) * 4096 + 2048 + voff[1][c]);
                    const bf16x8 vf = __builtin_shufflevector(lo, hh, 0, 1, 2, 3, 4, 5, 6, 7);
                    O[c] = AT_MFMA(vf, pf[s], O[c]);
                }
        }
        if (j + 1 < NT) AT_STORET(buf ^ 1);
        __syncthreads();
    }
    lsum = swap_add(lsum);
    const float inv = 1.0f / lsum;
    AT_LAS f32x4* xch = (AT_LAS f32x4*)(lds + qblk * 16384) + lane;
    if (map == 1) {
#pragma unroll
        for (int c = 0; c < 4; ++c)
#pragma unroll
            for (int g = 0; g < 4; ++g) xch[(c * 4 + g) * 64] = (f32x4){O[c][4 * g] * inv, O[c][4 * g + 1] * inv, O[c][4 * g + 2] * inv, O[c][4 * g + 3] * inv};
    }
    __syncthreads();
    if (map == 0) {
        float ms = 0.f;
#pragma unroll
        for (int c = 0; c < 4; ++c)
#pragma unroll
            for (int g = 0; g < 4; ++g) { const f32x4 o2 = xch[(c * 4 + g) * 64];
#pragma unroll
                for (int e = 0; e < 4; ++e) { const float o = O[c][4 * g + e] * inv - lam * o2[e]; O[c][4 * g + e] = o; ms += o * o; } }
        ms = swap_add(ms);
        const float rn = __builtin_amdgcn_rsqf(ms * (1.0f / 128.0f) + 1e-5f) * 0.8f;
        bf16_t* orow = cat + (size_t)qrow_g * 2048 + h * 128 + 4 * hi;
#pragma unroll
        for (int c = 0; c < 4; ++c)
#pragma unroll
            for (int g = 0; g < 4; ++g) { const f32x4 hg = *(const f32x4*)(head_g + 32 * c + 8 * g + 4 * hi);
                u32x2 w; w.x = cvtpk(O[c][4 * g] * rn * hg[0], O[c][4 * g + 1] * rn * hg[1]); w.y = cvtpk(O[c][4 * g + 2] * rn * hg[2], O[c][4 * g + 3] * rn * hg[3]);
                *(u32x2*)(orow + 32 * c + 8 * g) = w; }
    }
    __syncthreads();
#undef AT_LOADT
#undef AT_STORET
}
}

namespace cg = cooperative_groups;
#define GAS __attribute__((address_space(1)))
#define LAS __attribute__((address_space(3)))
typedef unsigned short bf16;
typedef unsigned v4u __attribute__((ext_vector_type(4)));
typedef unsigned v2u __attribute__((ext_vector_type(2)));
typedef float f32x4 __attribute__((ext_vector_type(4)));
constexpr int NWAVES = 8;
#ifndef DUP_SYNC
#define DUP_SYNC 0
#endif
#define GSYNC() do { grid.sync(); if (DUP_SYNC) grid.sync(); } while (0)
#define XSYNC() do { xcd_barrier(xbar); if (DUP_SYNC) xcd_barrier(xbar); } while (0)
#ifndef DUP_P3
#define DUP_P3 0
#endif
#ifndef DUP_P5
#define DUP_P5 0
#endif
#ifndef PROBE_SEAM
#define PROBE_SEAM 0
#endif
#define STAMP(k) do { if (PROBE_SEAM == (k) && bx == 0 && tid == 0) { const unsigned long long t_ = __builtin_amdgcn_s_memrealtime(); bar_st[4] = (unsigned)t_; bar_st[5] = (unsigned)(t_ >> 32); } } while (0)
#ifndef DUP_P0
#define DUP_P0 0
#endif
#ifndef DUP_P1
#define DUP_P1 0
#endif
#ifndef DUP_P2
#define DUP_P2 0
#endif
#ifndef DUP_P4
#define DUP_P4 0
#endif
constexpr int BATCH = 8, SEQ = 2048, DM = 2048, M = BATCH * SEQ, NMETA = 16, INW = 6144, DFF = 5632, NGU = 2 * DFF;
constexpr float NORM_EPS = 1e-6f;
constexpr float C2 = 0.125f * 1.4426950408889634f;
constexpr size_t MiB = 1u << 20;
constexpr size_t WS_CTL = 0, CTL_ZERO_BYTES = 1 * MiB;
constexpr size_t WS_BAR = 256 * 1024;
constexpr size_t WS_METAP = 1 * MiB;
constexpr size_t WS_MACC = 384 * 1024;
constexpr size_t WS_WIN = 6 * MiB, WS_WOUT = 30 * MiB, WS_WGU = 38 * MiB, WS_WDN = 82 * MiB;
constexpr size_t WS_A = 104 * MiB;
constexpr size_t WS_PROJ = 168 * MiB;
constexpr size_t WS_CAT = 360 * MiB, WS_END = 424 * MiB;
constexpr int LDS_BYTES = 147456;
constexpr int MP_KC = 8, MP_COLS = 5120;

__device__ __forceinline__ float wave_sum(float v) {
#pragma unroll
    for (int o = 1; o < 64; o <<= 1) v += __shfl_xor(v, o);
    return v;
}
__device__ __forceinline__ float bf2f(unsigned short h) { return __uint_as_float(((unsigned)h) << 16); }
#define LDS_WAIT() asm volatile("s_waitcnt lgkmcnt(0)" ::: "memory")

__device__ __forceinline__ void tr_item(const float* __restrict__ W, int N, int k0, int n0, const float* __restrict__ kscale, bf16* __restrict__ out, int out_ld, int out_row0, LAS float* scr, int lane,
                                        float* __restrict__ macc_, const float* __restrict__ metaw, const float* __restrict__ mg) {
    float v[64];
#pragma unroll
    for (int i = 0; i < 64; ++i) v[i] = __builtin_nontemporal_load(W + (size_t)(k0 + i) * N + n0 + lane);
#pragma unroll
    for (int i = 0; i < 64; ++i) { float t = v[i]; if (kscale) t *= kscale[k0 + i]; scr[i * 65 + lane] = t; }
    LDS_WAIT(); asm volatile("" ::: "memory");
    const int c = lane & 7;
#pragma unroll
    for (int j = 0; j < 8; ++j) { const int n = (lane >> 3) + 8 * j; const LAS float* s = scr + (8 * c) * 65 + n;
        v4u o; o.x = pg8::cvt_pk_bf16(s[0 * 65], s[1 * 65]); o.y = pg8::cvt_pk_bf16(s[2 * 65], s[3 * 65]); o.z = pg8::cvt_pk_bf16(s[4 * 65], s[5 * 65]); o.w = pg8::cvt_pk_bf16(s[6 * 65], s[7 * 65]);
        *(v4u*)(out + (size_t)(out_row0 + n) * out_ld + k0 + 8 * c) = o; }
    if (macc_) {
        float acc[16];
#pragma unroll
        for (int r = 0; r < 16; ++r) acc[r] = 0.f;
#pragma unroll 8
        for (int i = 0; i < 64; ++i) { const float w = scr[i * 65 + lane] * mg[k0 + i];
#pragma unroll
            for (int r = 0; r < 16; ++r) acc[r] = fmaf(metaw[r * 2048 + k0 + i], w, acc[r]); }
#pragma unroll
        for (int r = 0; r < 16; ++r) atomicAdd(macc_ + r * 5120 + (n0 - 1024) + lane, acc[r]);
    }
    LDS_WAIT(); asm volatile("" ::: "memory");
}

#define XB_TMO      128
#define XB_XCNT(j)  (256  + 64 * (j))
#define XB_XSUB(j)  (1280 + 64 * (j))
#define XB_XGEN(j)  (2304 + 64 * (j))
#define XB_TOP      3328
#define XB_TOPGEN   3392
#define XCD_BAR_WORDS 3456
#define XB_SPIN_CAP (1u << 18)

__device__ __forceinline__ unsigned xb_ld(unsigned* p)              { return __hip_atomic_load(p, __ATOMIC_RELAXED, __HIP_MEMORY_SCOPE_AGENT); }
__device__ __forceinline__ unsigned xb_add(unsigned* p, unsigned v) { return __hip_atomic_fetch_add(p, v, __ATOMIC_RELAXED, __HIP_MEMORY_SCOPE_AGENT); }
__device__ __forceinline__ unsigned xb_xcc_id() { return (unsigned)__builtin_amdgcn_s_getreg((3 << 11) | 20) & 0xFu; }
#define XB_SPIN(cond, bar) do { unsigned _sp = 0; while (cond) { __builtin_amdgcn_s_sleep(1); \
    if ((++_sp & 255u) == 0u) { if (xb_ld(&(bar)[XB_TMO])) break; if (_sp > XB_SPIN_CAP) { atomicAdd(&(bar)[XB_TMO], 1u); break; } } } } while (0)

struct XcdBarrier {
    unsigned* bar; unsigned x;
    volatile LAS unsigned* st;
};

__device__ __forceinline__ XcdBarrier xcd_barrier_post(unsigned* bar, volatile LAS unsigned* st) {
    XcdBarrier b; b.bar = bar; b.x = xb_xcc_id(); b.st = st;
    if (threadIdx.x == 0) (void)xb_add(&bar[XB_XCNT(b.x)], 1u);
    return b;
}
__device__ __forceinline__ void xcd_barrier_complete(unsigned* bar, unsigned x, unsigned& nloc, unsigned& nx) {
    const unsigned G = gridDim.x * gridDim.y * gridDim.z;
    unsigned sum, cnt, mine, sp = 0u;
    for (;;) {
        sum = 0u; cnt = 0u; mine = 0u;
#pragma unroll
        for (unsigned j = 0; j < 16; ++j) { const unsigned c = xb_ld(&bar[XB_XCNT(j)]); sum += c; cnt += (c > 0u) ? 1u : 0u; mine = (j == x) ? c : mine; }
        if (sum == G) break;
        __builtin_amdgcn_s_sleep(1);
        if ((++sp & 255u) == 0u) { if (xb_ld(&bar[XB_TMO])) break; if (sp > XB_SPIN_CAP) { atomicAdd(&bar[XB_TMO], 1u); break; } }
    }
    nloc = mine > 0u ? mine : 1u; nx = cnt > 0u ? cnt : 1u;
}

__device__ __forceinline__ void xcd_barrier(const XcdBarrier& b) {
    asm volatile("s_waitcnt vmcnt(0)" ::: "memory");
    __syncthreads();
    if (threadIdx.x == 0) {
        unsigned* bar = b.bar;
        __builtin_amdgcn_s_waitcnt(0);
        unsigned nloc = b.st[0], nx = b.st[1];
        if (nloc == 0u) { xcd_barrier_complete(bar, b.x, nloc, nx); b.st[0] = nloc; b.st[1] = nx; }
        const unsigned old = xb_add(&bar[XB_XSUB(b.x)], 1u);
        const unsigned gen = old / nloc;
        if (old + 1u == (gen + 1u) * nloc) {
            __builtin_amdgcn_fence(__ATOMIC_RELEASE, "agent");
            asm volatile("s_waitcnt vmcnt(0)" ::: "memory");
            const unsigned og = xb_add(&bar[XB_TOP], 1u);
            const unsigned tg = og / nx;
            if (og + 1u == (tg + 1u) * nx) xb_add(&bar[XB_TOPGEN], 1u);
            else XB_SPIN(xb_ld(&bar[XB_TOPGEN]) == tg, bar);
            __builtin_amdgcn_fence(__ATOMIC_ACQUIRE, "agent");
            xb_add(&bar[XB_XGEN(b.x)], 1u);
            asm volatile("s_waitcnt vmcnt(0)" ::: "memory");
        } else {
            XB_SPIN(xb_ld(&bar[XB_XGEN(b.x)]) == gen, bar);
            __builtin_amdgcn_fence(__ATOMIC_ACQUIRE, "agent");
            asm volatile("s_waitcnt vmcnt(0)" ::: "memory");
        }
    }
    __syncthreads();
}

struct Args { const float* in[16]; float* out; unsigned char* ws; };

__global__ void __launch_bounds__(NWAVES * 64, 2) hymba_fwd(Args args) {
    extern __shared__ __attribute__((aligned(16))) unsigned char lds_raw[];
    cg::grid_group grid = cg::this_grid();
    LAS unsigned char* lds = (LAS unsigned char*)lds_raw;
    const int tid = threadIdx.x, lane = tid & 63, wave = __builtin_amdgcn_readfirstlane(tid >> 6);
    const int G = gridDim.x, bx = blockIdx.x;
    const int vcu = (G % 8 == 0) ? (bx % 8) * (G / 8) + bx / 8 : bx;
    const int gw = __builtin_amdgcn_readfirstlane(vcu * NWAVES + wave), NGW = G * NWAVES;
    volatile LAS unsigned* bar_st = (volatile LAS unsigned*)(lds + 139264);
    if (tid < 2) bar_st[tid] = 0u;
    if (PROBE_SEAM && bx == 0 && tid == 0) { const unsigned long long t_ = __builtin_amdgcn_s_memrealtime(); bar_st[2] = (unsigned)t_; bar_st[3] = (unsigned)(t_ >> 32); }
    __syncthreads();
    const XcdBarrier xbar = xcd_barrier_post((unsigned*)(args.ws + WS_BAR), bar_st);
#define WSP (args.ws)
#define XIN (args.in[0])
#define meta (args.in[1])
#define g1 (args.in[2])
#define w_in (args.in[3])
#define head_g (args.in[8])
#define conv_w (args.in[9])
#define w_out (args.in[10])
#define g2 (args.in[11])
#define w_gate (args.in[12])
#define w_up (args.in[13])
#define w_down (args.in[14])
#define gf (args.in[15])
#define OUTP (args.out)
#define ssq1 ((float*)(WSP + WS_CTL))
#define ssq2 (((float*)(WSP + WS_CTL)) + M)
#define metap ((bf16*)(WSP + WS_METAP))
#define macc ((float*)(WSP + WS_MACC))
#define Win_t ((bf16*)(WSP + WS_WIN))
#define Wout_t ((bf16*)(WSP + WS_WOUT))
#define Wgu_t ((bf16*)(WSP + WS_WGU))
#define Wdn_t ((bf16*)(WSP + WS_WDN))
#define Abuf ((bf16*)(WSP + WS_A))
#define proj ((bf16*)(WSP + WS_PROJ))
#define act ((bf16*)(WSP + WS_PROJ))
#define cat ((bf16*)(WSP + WS_CAT))
    {
        LAS float* scr = (LAS float*)(lds + wave * 16640);
        constexpr int I_IN = 32 * 96, I_OUT = 32 * 32, I_G = 32 * 88, I_D = 88 * 32, NITEMS = I_IN + I_OUT + 2 * I_G + I_D;
        for (int it = gw; it < NITEMS * (1 + DUP_P0); it += NGW) {
            int r = it % NITEMS;
            if (r < I_IN) { const int n0 = 64 * (r % 96); tr_item(w_in, INW, 64 * (r / 96), n0, nullptr, Win_t, DM, n0, scr, lane, n0 >= 1024 ? macc : nullptr, meta, g1); continue; } r -= I_IN;
            if (r < I_OUT) { tr_item(w_out, DM, 64 * (r / 32), 64 * (r % 32), nullptr, Wout_t, DM, 64 * (r % 32), scr, lane, nullptr, nullptr, nullptr); continue; } r -= I_OUT;
            if (r < I_G) { const int n0 = 64 * (r % 88); tr_item(w_gate, DFF, 64 * (r / 88), n0, g2, Wgu_t, DM, 256 * (n0 / 128) + (n0 % 128), scr, lane, nullptr, nullptr, nullptr); continue; } r -= I_G;
            if (r < I_G) { const int n0 = 64 * (r % 88); tr_item(w_up, DFF, 64 * (r / 88), n0, g2, Wgu_t, DM, 256 * (n0 / 128) + 128 + (n0 % 128), scr, lane, nullptr, nullptr, nullptr); continue; } r -= I_G;
            tr_item(w_down, DM, 64 * (r / 32), 64 * (r % 32), nullptr, Wdn_t, DFF, 64 * (r % 32), scr, lane, nullptr, nullptr, nullptr);
        }
        for (int m_ = gw; m_ < (M / 2) * (1 + DUP_P0); m_ += NGW) { const int m = (m_ % (M / 2)) * 2;
            const f32x4* xr = (const f32x4*)(XIN + (size_t)m * DM) + lane; f32x4 v[2][8]; float s[2] = {0.f, 0.f};
#pragma unroll
            for (int q = 0; q < 2; ++q)
#pragma unroll
                for (int j = 0; j < 8; ++j) v[q][j] = __builtin_nontemporal_load(xr + q * (DM / 4) + 64 * j);
#pragma unroll
            for (int q = 0; q < 2; ++q)
#pragma unroll
                for (int j = 0; j < 8; ++j) s[q] += (v[q][j].x * v[q][j].x + v[q][j].y * v[q][j].y) + (v[q][j].z * v[q][j].z + v[q][j].w * v[q][j].w);
#pragma unroll
            for (int q = 0; q < 2; ++q) {
                const float rs = __builtin_amdgcn_rsqf(wave_sum(s[q]) * (1.0f / DM) + NORM_EPS);
                v2u* o8 = (v2u*)(Abuf + (size_t)(m + q) * DM) + lane;
#pragma unroll
                for (int j = 0; j < 8; ++j) { const f32x4 g = ((const f32x4*)g1)[64 * j + lane]; v2u w; w.x = pg8::cvt_pk_bf16(v[q][j].x * rs * g.x, v[q][j].y * rs * g.y); w.y = pg8::cvt_pk_bf16(v[q][j].z * rs * g.z, v[q][j].w * rs * g.w); o8[64 * j] = w; }
            }
        }
    }
    GSYNC();
    STAMP(1);

    if (bx < 16) {
        const int r = bx; float s = 0.f;
        for (int k = lane; k < DM; k += 64) { const float v = meta[r * DM + k]; s += v * v; }
        const float rs = __builtin_amdgcn_rsqf(wave_sum(s) * (1.0f / DM) + NORM_EPS);
        for (int c = tid; c < MP_COLS; c += NWAVES * 64) { const float a = macc[(size_t)r * MP_COLS + c];
            metap[(size_t)r * INW + 1024 + c] = (bf16)(pg8::cvt_pk_bf16(a * rs, 0.f) & 0xffffu); }
    }
    {
        pg8::Gemm g{Abuf, Win_t, M, INW, DM}; pg8::StaticOrder S; S.init(M, INW, G, bx); S.reps = 1 + DUP_P1;
        pg8::EpiProj E{proj, C2};
        pg8::gemm_phase<pg8::EpiProj, pg8::StaticOrder, true, true>(lds, g, S, E);
    }
    XSYNC();
    STAMP(2);

    {
        float lam;
        { const float a = args.in[4][lane] * args.in[5][lane], c = args.in[6][lane] * args.in[7][lane];
          lam = __expf(wave_sum(a)) - __expf(wave_sum(c)) + 0.2f; }
        for (int pi_ = vcu; pi_ < 512 * (1 + DUP_P2); pi_ += G) { const int pi = pi_ & 511;
            const int bh = pi >> 3, s = pi & 7;
            at::attn_unit(lds, proj, metap, cat, head_g, bh >> 3, bh & 7, 15 - s, lam);
            at::attn_unit(lds, proj, metap, cat, head_g, bh >> 3, bh & 7, s, lam);
        }
        for (int idx_ = vcu * (NWAVES * 64) + tid; idx_ < M * 128 * (1 + DUP_P2); idx_ += G * NWAVES * 64) { const int idx = idx_ % (M * 128);
            const int row = idx >> 7, c8 = (idx & 127) * 8, s = row & (SEQ - 1);
            const bf16* r0 = proj + (size_t)row * INW;
            const bf16* r1 = s >= 1 ? r0 - INW : metap + (size_t)15 * INW;
            const bf16* r2 = s >= 2 ? r0 - 2 * INW : metap + (size_t)(14 + s) * INW;
            const v4u bgv = *(const v4u*)(r0 + 3072 + c8), c0v = *(const v4u*)(r0 + 4096 + c8), h0v = *(const v4u*)(r0 + 5120 + c8);
            const v4u c1v = *(const v4u*)(r1 + 4096 + c8), h1v = *(const v4u*)(r1 + 5120 + c8), c2v = *(const v4u*)(r2 + 4096 + c8), h2v = *(const v4u*)(r2 + 5120 + c8);
            float y[8];
#pragma unroll
            for (int e = 0; e < 8; ++e) {
                const int w = e >> 1, sh = (e & 1) * 16;
                const float bg = __uint_as_float((bgv[w] >> sh) << 16), u0 = __uint_as_float((c0v[w] >> sh) << 16) * __uint_as_float((h0v[w] >> sh) << 16);
                const float u1 = __uint_as_float((c1v[w] >> sh) << 16) * __uint_as_float((h1v[w] >> sh) << 16), u2 = __uint_as_float((c2v[w] >> sh) << 16) * __uint_as_float((h2v[w] >> sh) << 16);
                y[e] = bg * (conv_w[c8 + e] * u2 + conv_w[1024 + c8 + e] * u1 + conv_w[2048 + c8 + e] * u0);
            }
            v4u o; o.x = pg8::cvt_pk_bf16(y[0], y[1]); o.y = pg8::cvt_pk_bf16(y[2], y[3]); o.z = pg8::cvt_pk_bf16(y[4], y[5]); o.w = pg8::cvt_pk_bf16(y[6], y[7]);
            *(v4u*)(cat + (size_t)row * DM + 1024 + c8) = o;
        }
    }
    XSYNC();
    STAMP(3);

    {
        pg8::Gemm g{cat, Wout_t, M, DM, DM}; pg8::StaticOrder S; S.init(M, DM, G, bx); S.reps = 1 + DUP_P3;
        pg8::EpiRes1 E{XIN, Abuf, ssq1, 2 * M};
        pg8::gemm_phase<pg8::EpiRes1, pg8::StaticOrder, true, true>(lds, g, S, E);
    }
    XSYNC();
    STAMP(4);

    {
        pg8::Gemm g{Abuf, Wgu_t, M, NGU, DM}; pg8::StaticOrder S; S.init(M, NGU, G, bx); S.reps = 1 + DUP_P4;
        pg8::EpiGU E{act, ssq1};
        pg8::gemm_phase<pg8::EpiGU, pg8::StaticOrder, true, true>(lds, g, S, E);
    }
    XSYNC();
    STAMP(5);

    {
        pg8::Gemm g{act, Wdn_t, M, DM, DFF}; pg8::StaticOrder S; S.init(M, DM, G, bx); S.reps = 1 + DUP_P5;
        pg8::EpiRes2 E{Abuf, cat, ssq2, M};
        pg8::gemm_phase<pg8::EpiRes2, pg8::StaticOrder, true, true>(lds, g, S, E);
    }
    XSYNC();
    STAMP(6);

    for (int m = gw; m < M; m += NGW) {
        const float rs = __builtin_amdgcn_rsqf(ssq2[m] * (1.0f / DM) + NORM_EPS);
        const v4u* hr = (const v4u*)(cat + (size_t)m * DM) + lane;
        f32x4* o = (f32x4*)(OUTP + (size_t)m * DM);
        v4u hv[4];
#pragma unroll
        for (int j = 0; j < 4; ++j) hv[j] = hr[64 * j];
#pragma unroll
        for (int j = 0; j < 4; ++j) { const int c8 = (64 * j + lane) * 2; const f32x4 ga = ((const f32x4*)gf)[c8], gb = ((const f32x4*)gf)[c8 + 1];
            f32x4 va, vb; va.x = pg8::bflo(hv[j].x) * rs * ga.x; va.y = pg8::bfhi(hv[j].x) * rs * ga.y; va.z = pg8::bflo(hv[j].y) * rs * ga.z; va.w = pg8::bfhi(hv[j].y) * rs * ga.w;
            vb.x = pg8::bflo(hv[j].z) * rs * gb.x; vb.y = pg8::bfhi(hv[j].z) * rs * gb.y; vb.z = pg8::bflo(hv[j].w) * rs * gb.z; vb.w = pg8::bfhi(hv[j].w) * rs * gb.w;
            __builtin_nontemporal_store(va, o + c8); __builtin_nontemporal_store(vb, o + c8 + 1); }
    }
    if (PROBE_SEAM && bx == 0 && tid == 0) {
        const unsigned long long t0_ = ((unsigned long long)bar_st[3] << 32) | bar_st[2], t1_ = ((unsigned long long)bar_st[5] << 32) | bar_st[4];
        const unsigned long long wait_ = 8ull * (t1_ - t0_), s0_ = __builtin_amdgcn_s_memrealtime();
        while (__builtin_amdgcn_s_memrealtime() - s0_ < wait_) __builtin_amdgcn_s_sleep(32);
    }
}

#undef WSP
#undef XIN
#undef meta
#undef g1
#undef w_in
#undef head_g
#undef conv_w
#undef w_out
#undef g2
#undef w_gate
#undef w_up
#undef w_down
#undef gf
#undef OUTP
#undef ssq1
#undef ssq2
#undef metap
#undef macc
#undef Win_t
#undef Wout_t
#undef Wgu_t
#undef Wdn_t
#undef Abuf
#undef proj
#undef act
#undef cat

extern "C" void kernel_launch(void* const* d_in, const int* in_sizes, int n_in, void* d_out, int out_size, void* d_ws, size_t ws_size, hipStream_t stream) {
    static int grid_blocks = 0;
    if (grid_blocks == 0) {
        if (n_in != 16 || in_sizes[0] != M * DM || out_size != M * DM || ws_size < WS_END) { fprintf(stderr, "kernel_launch: unexpected shapes (n_in %d, in0 %d, out %d, ws %zu)\n", n_in, n_in > 0 ? in_sizes[0] : -1, out_size, ws_size); grid_blocks = -1; return; }
        int dev = 0, cus = 0, per_cu = 0;
        (void)hipGetDevice(&dev); (void)hipDeviceGetAttribute(&cus, hipDeviceAttributeMultiprocessorCount, dev);
        if (hipFuncSetAttribute((const void*)hymba_fwd, hipFuncAttributeMaxDynamicSharedMemorySize, LDS_BYTES) != hipSuccess) fprintf(stderr, "kernel_launch: hipFuncSetAttribute failed\n");
        if (hipOccupancyMaxActiveBlocksPerMultiprocessor(&per_cu, (const void*)hymba_fwd, NWAVES * 64, LDS_BYTES) != hipSuccess || per_cu < 1) { fprintf(stderr, "kernel_launch: occupancy query gave %d\n", per_cu); per_cu = 1; }
        (void)hipGetLastError();
        grid_blocks = cus * per_cu;
    }
    if (grid_blocks < 0) return;
    (void)hipMemsetAsync((char*)d_ws + WS_CTL, 0, CTL_ZERO_BYTES, stream);
    Args a{};
    for (int i = 0; i < 16; ++i) a.in[i] = (const float*)d_in[i];
    a.out = (float*)d_out; a.ws = (unsigned char*)d_ws;
    void* kargs[] = {&a};
    hipError_t e = hipLaunchCooperativeKernel((const void*)hymba_fwd, dim3(grid_blocks), dim3(NWAVES * 64), kargs, LDS_BYTES, stream);
    if (e != hipSuccess) fprintf(stderr, "cooperative launch failed: %s (grid %d)\n", hipGetErrorString(e), grid_blocks);
}
```

```cpp
#include <hip/hip_runtime.h>
#include <hip/hip_cooperative_groups.h>
#include <cstdio>
#include <cstdint>
#include <cmath>
namespace pg8 {
#define PG8_LAS __attribute__((address_space(3)))
typedef unsigned short bf16_t;
typedef short bf16x8 __attribute__((ext_vector_type(8)));
typedef float f32x4 __attribute__((ext_vector_type(4)));
typedef unsigned u32x4 __attribute__((ext_vector_type(4)));
constexpr int BM = 256, BK = 64, HALF = 128, HTB = HALF * BK * 2  , STAGE_BYTES = 8 * HTB, NXCD = 8, WGM = 8;

__host__ __device__ __forceinline__ int lds_byte(int r, int c) { const int st = (r >> 4) * 2 + (c >> 5), rr = r & 15, cc = c & 31, ob = rr * 64 + cc * 2; return st * 1024 + (ob ^ (((ob >> 9) & 1) << 5)); }
__host__ __device__ __forceinline__ void stage_rc(int b, int& R, int& C) { const int st = b / 1024, sb = b % 1024, swz = sb ^ (((sb >> 9) & 1) << 5); R = (st >> 1) * 16 + swz / 64; C = (st & 1) * 32 + (swz % 64) / 2; }
__host__ __device__ __forceinline__ int perm32(int rho) { const int n = rho >> 4, i = rho & 15; return 8 * (i >> 2) + 4 * n + (i & 3); }

struct Unit { int pm, pn, last; };
struct Gemm { const bf16_t* A; const bf16_t* Bt; int M, N, K; };

struct StaticOrder {
    int nM, nN, nwg, G, c, reps = 1;
    __host__ __device__ void init(int M, int N, int G_, int c_) { nM = M / BM; nN = N / BM; nwg = nM * nN; G = G_; c = c_; }
    __host__ __device__ bool next(int i, Unit& u) const {
        const long L = (long)i * G + c; if (L >= (long)nwg * reps) return false;
        int wgid = (int)(L % nwg); u.last = (L / nwg == reps - 1); { const int q = nwg / NXCD, r = nwg % NXCD, xcd = wgid % NXCD, off = wgid / NXCD; wgid = (xcd < r ? xcd * (q + 1) : r * (q + 1) + (xcd - r) * q) + off; }
        const int nig = WGM * nN, gid = wgid / nig, fm = gid * WGM, gsz = (nM - fm) < WGM ? (nM - fm) : WGM;
        u.pm = fm + ((wgid % nig) % gsz); u.pn = (wgid % nig) / gsz; return true;
    }
    __device__ __forceinline__ void a_ready(const Unit&) const {}
    __device__ __forceinline__ void done(const Unit&) const {}
};

__device__ __forceinline__ unsigned cvt_pk_bf16(float lo, float hi) { unsigned r; asm volatile("v_cvt_pk_bf16_f32 %0, %1, %2" : "=v"(r) : "v"(lo), "v"(hi)); return r; }
typedef float f32x2 __attribute__((ext_vector_type(2)));
struct EpiProj {
    static constexpr bool PERM = true, AFTER_DRAIN = false;
    bf16_t* O; float qscale;
    __device__ __forceinline__ void operator()(const f32x4 (&acc)[2][2][4][2], const Unit& u, int wr, int wc, int fr, int fq) const {
        const int row0 = u.pm * BM + wr * 64 + fr; const int colt = u.pn * BM;
        const float sc = (colt < 1024) ? qscale : 1.f;
        const int col0 = colt + wc * 32 + 8 * fq;
#pragma unroll
        for (int ai = 0; ai < 2; ++ai)
#pragma unroll
            for (int m = 0; m < 4; ++m) { bf16_t* rowp = O + (size_t)(row0 + ai * HALF + m * 16) * 6144 + col0;
#pragma unroll
                for (int bj = 0; bj < 2; ++bj) { const f32x4 v0 = acc[ai][bj][m][0] * sc, v1 = acc[ai][bj][m][1] * sc;
                    u32x4 w; w.x = cvt_pk_bf16(v0[0], v0[1]); w.y = cvt_pk_bf16(v0[2], v0[3]); w.z = cvt_pk_bf16(v1[0], v1[1]); w.w = cvt_pk_bf16(v1[2], v1[3]);
                    *(u32x4*)(rowp + bj * HALF) = w; } }
    }
};
__device__ __forceinline__ float bflo(unsigned w) { return __uint_as_float(w << 16); }
__device__ __forceinline__ float bfhi(unsigned w) { return __uint_as_float(w & 0xffff0000u); }
struct EpiRes1 {
    static constexpr bool PERM = true, AFTER_DRAIN = false;
    const float* __restrict__ xs; const float* __restrict__ g1v; bf16_t* Hb; float* __restrict__ ssq_; int dup_off;
    __device__ __forceinline__ void operator()(const f32x4 (&acc)[2][2][4][2], const Unit& u, int wr, int wc, int fr, int fq) const {
        float* ssq = ssq_ + (u.last ? 0 : dup_off);
        const int row0 = u.pm * BM + wr * 64 + fr; const int col0 = u.pn * BM + wc * 32 + 8 * fq;
        f32x4 ig[2][2];
#pragma unroll
        for (int bj = 0; bj < 2; ++bj)
#pragma unroll
            for (int n = 0; n < 2; ++n) { const f32x4 g = *(const f32x4*)(g1v + col0 + bj * HALF + 4 * n);
                ig[bj][n] = (f32x4){__builtin_amdgcn_rcpf(g[0]), __builtin_amdgcn_rcpf(g[1]), __builtin_amdgcn_rcpf(g[2]), __builtin_amdgcn_rcpf(g[3])}; }
#pragma unroll
        for (int g2 = 0; g2 < 4; ++g2) { const int ai = g2 >> 1, mb = (g2 & 1) * 2;
            u32x4 pre[2][2]; float xsr[2];
#pragma unroll
            for (int mm = 0; mm < 2; ++mm) { const int row = row0 + ai * HALF + (mb + mm) * 16; xsr[mm] = xs[row];
#pragma unroll
                for (int bj = 0; bj < 2; ++bj) pre[mm][bj] = *(const u32x4*)(Hb + (size_t)row * 2048 + col0 + bj * HALF); }
            asm volatile("" ::: "memory");
#pragma unroll
            for (int mm = 0; mm < 2; ++mm) { const int m = mb + mm; const int row = row0 + ai * HALF + m * 16; float ss = 0.f;
#pragma unroll
                for (int bj = 0; bj < 2; ++bj) { const size_t off = (size_t)row * 2048 + col0 + bj * HALF; const u32x4 xr = pre[mm][bj];
                    const f32x4 x0 = (f32x4){bflo(xr.x), bfhi(xr.x), bflo(xr.y), bfhi(xr.y)} * ig[bj][0] * xsr[mm], x1 = (f32x4){bflo(xr.z), bfhi(xr.z), bflo(xr.w), bfhi(xr.w)} * ig[bj][1] * xsr[mm];
                    const f32x4 v0 = acc[ai][bj][m][0] + x0, v1 = acc[ai][bj][m][1] + x1;
                    u32x4 w; w.x = cvt_pk_bf16(v0[0], v0[1]); w.y = cvt_pk_bf16(v0[2], v0[3]); w.z = cvt_pk_bf16(v1[0], v1[1]); w.w = cvt_pk_bf16(v1[2], v1[3]); *(u32x4*)(Hb + off) = w;
                    ss += (v0[0] * v0[0] + v0[1] * v0[1]) + (v0[2] * v0[2] + v0[3] * v0[3]) + (v1[0] * v1[0] + v1[1] * v1[1]) + (v1[2] * v1[2] + v1[3] * v1[3]); }
                ss += __shfl_xor(ss, 16); ss += __shfl_xor(ss, 32);
                if (fq == 0) atomicAdd(ssq + row, ss); }
        }
    }
};
struct EpiRes2 {
    static constexpr bool PERM = true, AFTER_DRAIN = false;
    const bf16_t* __restrict__ X; bf16_t* __restrict__ Hb; float* __restrict__ ssq_; int dup_off;
    __device__ __forceinline__ void operator()(const f32x4 (&acc)[2][2][4][2], const Unit& u, int wr, int wc, int fr, int fq) const {
        float* ssq = ssq_ + (u.last ? 0 : dup_off);
        const int row0 = u.pm * BM + wr * 64 + fr; const int col0 = u.pn * BM + wc * 32 + 8 * fq;
#pragma unroll
        for (int ai = 0; ai < 2; ++ai) {
            u32x4 pre[4][2];
#pragma unroll
            for (int m = 0; m < 4; ++m)
#pragma unroll
                for (int bj = 0; bj < 2; ++bj) pre[m][bj] = *(const u32x4*)(X + (size_t)(row0 + ai * HALF + m * 16) * 2048 + col0 + bj * HALF);
            asm volatile("" ::: "memory");
#pragma unroll
            for (int m = 0; m < 4; ++m) { const int row = row0 + ai * HALF + m * 16; float ss = 0.f;
#pragma unroll
                for (int bj = 0; bj < 2; ++bj) { const size_t off = (size_t)row * 2048 + col0 + bj * HALF; const u32x4 xr = pre[m][bj];
                    const f32x4 v0 = acc[ai][bj][m][0] + (f32x4){bflo(xr.x), bfhi(xr.x), bflo(xr.y), bfhi(xr.y)}, v1 = acc[ai][bj][m][1] + (f32x4){bflo(xr.z), bfhi(xr.z), bflo(xr.w), bfhi(xr.w)};
                    u32x4 w; w.x = cvt_pk_bf16(v0[0], v0[1]); w.y = cvt_pk_bf16(v0[2], v0[3]); w.z = cvt_pk_bf16(v1[0], v1[1]); w.w = cvt_pk_bf16(v1[2], v1[3]); *(u32x4*)(Hb + off) = w;
                    ss += (v0[0] * v0[0] + v0[1] * v0[1]) + (v0[2] * v0[2] + v0[3] * v0[3]) + (v1[0] * v1[0] + v1[1] * v1[1]) + (v1[2] * v1[2] + v1[3] * v1[3]); }
                ss += __shfl_xor(ss, 16); ss += __shfl_xor(ss, 32);
                if (fq == 0) atomicAdd(ssq + row, ss); }
        }
    }
};
struct EpiGU {
    static constexpr bool PERM = true, AFTER_DRAIN = false;
    bf16_t* O; const float* ssq;
    __device__ __forceinline__ void operator()(const f32x4 (&acc)[2][2][4][2], const Unit& u, int wr, int wc, int fr, int fq) const {
        const int row0 = u.pm * BM + wr * 64 + fr; const int col0 = u.pn * HALF + wc * 32 + 8 * fq;
#pragma unroll
        for (int ai = 0; ai < 2; ++ai)
#pragma unroll
            for (int m = 0; m < 4; ++m) { const int row = row0 + ai * HALF + m * 16;
                const float rs = __builtin_amdgcn_rsqf(ssq[row] * (1.0f / 2048.0f) + 1e-6f);
                float a[8];
#pragma unroll
                for (int n = 0; n < 2; ++n)
#pragma unroll
                    for (int e = 0; e < 4; ++e) { const float g = acc[ai][0][m][n][e] * rs, up = acc[ai][1][m][n][e] * rs;
                        a[n * 4 + e] = g * __builtin_amdgcn_rcpf(1.0f + __builtin_amdgcn_exp2f(-1.4426950408889634f * g)) * up; }
                u32x4 w; w.x = cvt_pk_bf16(a[0], a[1]); w.y = cvt_pk_bf16(a[2], a[3]); w.z = cvt_pk_bf16(a[4], a[5]); w.w = cvt_pk_bf16(a[6], a[7]);
                *(u32x4*)(O + (size_t)row * 5632 + col0) = w; }
    }
};
template <class Epi, class Sched, bool ALIGN_EPI = false, bool SP2 = false>
__device__ __forceinline__ void gemm_phase(PG8_LAS unsigned char* lds, const Gemm g, const Sched& S, const Epi& E) {
    const int tid = threadIdx.x, wid = __builtin_amdgcn_readfirstlane(tid >> 6), lane = tid & 63, wr = wid >> 2, wc = wid & 3, fr = lane & 15, fq = lane >> 4;
    const int K = g.K, nt = K / BK;
    unsigned voffA[2], voffB[2];
#pragma unroll
    for (int i = 0; i < 2; ++i) { int R, C; stage_rc(tid * 16 + i * 8192, R, C); const int Rb = Epi::PERM ? ((R & ~31) + perm32(R & 31)) : R;
        voffA[i] = (unsigned)(R * K + C) * 2u; voffB[i] = (unsigned)(Rb * K + C) * 2u; }
    const size_t kstep = (size_t)(BK * 2);
    const size_t hstep = (size_t)HALF * K * 2;
    const size_t tstep = 2 * hstep;
    const unsigned ldsw = (unsigned)wid * 1024u;
    const int aoff = lds_byte(wr * 64 + fr, fq * 8), boff = lds_byte(wc * 32 + fr, fq * 8);
#define PG8_SA(b, h) (((b) * 2 + (h)) * HTB)
#define PG8_SB(b, h) ((4 + (b) * 2 + (h)) * HTB)
#define PG8_STAGE(bufoff, gbase, voff) do { _Pragma("unroll") for (int _i = 0; _i < 2; ++_i) \
        __builtin_amdgcn_global_load_lds((const unsigned*)((const char*)(gbase) + (voff)[_i]), (PG8_LAS unsigned*)(lds + (bufoff) + ldsw + _i * 8192), 16, 0, 0); } while (0)
#define PG8_LDA(dst, b, h) do { _Pragma("unroll") for (int m = 0; m < 4; ++m) _Pragma("unroll") for (int k = 0; k < 2; ++k) dst[m][k] = *(const PG8_LAS bf16x8*)(lds + PG8_SA(b, h) + aoff + m * 2048 + k * 1024); } while (0)
#define PG8_LDB(dst, b, h) do { _Pragma("unroll") for (int n = 0; n < 2; ++n) _Pragma("unroll") for (int k = 0; k < 2; ++k) dst[n][k] = *(const PG8_LAS bf16x8*)(lds + PG8_SB(b, h) + boff + n * 2048 + k * 1024); } while (0)
#define PG8_MMA(ai, bj, At, Bt) do { __builtin_amdgcn_s_setprio(1); _Pragma("unroll") for (int m = 0; m < 4; ++m) _Pragma("unroll") for (int n = 0; n < 2; ++n) _Pragma("unroll") for (int k = 0; k < 2; ++k) \
        acc[ai][bj][m][n] = __builtin_amdgcn_mfma_f32_16x16x32_bf16(Bt[n][k], At[m][k], acc[ai][bj][m][n], 0, 0, 0); __builtin_amdgcn_s_setprio(0); } while (0)
#define PG8_WAIT_V(n) asm volatile("s_waitcnt vmcnt(" #n ")" ::: "memory")
#define PG8_WAIT_L(n) asm volatile("s_waitcnt lgkmcnt(" #n ")" ::: "memory")
#define PG8_BAR __builtin_amdgcn_s_barrier()
#define PG8_SCHED __builtin_amdgcn_sched_barrier(0)
    Unit cur, nxt; int ui = 0;
    if (!S.next(0, cur)) return;
    f32x4 acc[2][2][4][2];
#pragma unroll
    for (int a = 0; a < 2; ++a)
#pragma unroll
        for (int b = 0; b < 2; ++b)
#pragma unroll
            for (int m = 0; m < 4; ++m)
#pragma unroll
                for (int n = 0; n < 2; ++n) acc[a][b][m][n] = (f32x4){0.f, 0.f, 0.f, 0.f};
    bf16x8 At[4][2], B0[2][2], B1[2][2];
    const char* cA = (const char*)g.A + (size_t)cur.pm * tstep; const char* cB = (const char*)g.Bt + (size_t)cur.pn * tstep;
    S.a_ready(cur);
    if constexpr (SP2) {
        PG8_STAGE(PG8_SB(0, 0), cB, voffB); PG8_STAGE(PG8_SB(0, 1), cB + hstep, voffB); PG8_STAGE(PG8_SA(0, 0), cA, voffA); PG8_STAGE(PG8_SA(0, 1), cA + hstep, voffA);
        if (wr == 1) PG8_BAR;
        PG8_WAIT_V(2); PG8_BAR;
        PG8_STAGE(PG8_SB(1, 0), cB + kstep, voffB); PG8_STAGE(PG8_SA(1, 0), cA + kstep, voffA); PG8_STAGE(PG8_SB(1, 1), cB + hstep + kstep, voffB);
        PG8_WAIT_V(6); PG8_BAR;
    } else {
        PG8_STAGE(PG8_SB(0, 0), cB, voffB); PG8_STAGE(PG8_SA(0, 0), cA, voffA); PG8_STAGE(PG8_SB(0, 1), cB + hstep, voffB); PG8_STAGE(PG8_SA(0, 1), cA + hstep, voffA);
        if (wr == 1) PG8_BAR;
        PG8_WAIT_V(4); PG8_BAR;
        PG8_STAGE(PG8_SB(1, 0), cB + kstep, voffB); PG8_STAGE(PG8_SA(1, 0), cA + kstep, voffA); PG8_STAGE(PG8_SB(1, 1), cB + hstep + kstep, voffB);
        PG8_WAIT_V(6); PG8_BAR;
    }
    for (;;) {
        const bool has_next = S.next(ui + 1, nxt);
        const char* nA = has_next ? (const char*)g.A + (size_t)nxt.pm * tstep : cA; const char* nB = has_next ? (const char*)g.Bt + (size_t)nxt.pn * tstep : cB;
        for (int t = 0; t < nt; t += 2) {
            const bool last = (t == nt - 2);
            const char* a1 = cA + (size_t)(t + 1) * kstep;
            const char* a2 = last ? nA : cA + (size_t)(t + 2) * kstep; const char* b2 = last ? nB : cB + (size_t)(t + 2) * kstep;
            const char* a3 = a2 + kstep; const char* b3 = b2 + kstep;
            if (last && has_next) S.a_ready(nxt);
            if constexpr (SP2) {
            PG8_LDB(B0, 0, 0); PG8_LDB(B1, 0, 1); PG8_SCHED; PG8_LDA(At, 0, 0); PG8_STAGE(PG8_SA(1, 1), a1 + hstep, voffA);
            PG8_WAIT_V(8); PG8_WAIT_L(0); PG8_BAR; PG8_MMA(0, 0, At, B0); PG8_MMA(0, 1, At, B1); PG8_BAR; PG8_SCHED;
            PG8_LDA(At, 0, 1); PG8_STAGE(PG8_SB(0, 0), b2, voffB); PG8_STAGE(PG8_SB(0, 1), b2 + hstep, voffB); PG8_STAGE(PG8_SA(0, 0), a2, voffA);
            PG8_WAIT_V(8); PG8_WAIT_L(0); PG8_BAR; PG8_MMA(1, 0, At, B0); PG8_MMA(1, 1, At, B1); PG8_BAR; PG8_SCHED;
            PG8_LDB(B0, 1, 0); PG8_LDB(B1, 1, 1); PG8_SCHED; PG8_LDA(At, 1, 0); PG8_STAGE(PG8_SA(0, 1), a2 + hstep, voffA);
            PG8_WAIT_V(8); PG8_WAIT_L(0); PG8_BAR; PG8_MMA(0, 0, At, B0); PG8_MMA(0, 1, At, B1); PG8_BAR; PG8_SCHED;
            PG8_LDA(At, 1, 1); PG8_STAGE(PG8_SB(1, 0), b3, voffB); PG8_STAGE(PG8_SB(1, 1), b3 + hstep, voffB); PG8_STAGE(PG8_SA(1, 0), a3, voffA);
            PG8_WAIT_V(8); PG8_WAIT_L(0); PG8_BAR; PG8_MMA(1, 0, At, B0); PG8_MMA(1, 1, At, B1); PG8_BAR; PG8_SCHED;
            } else {
            PG8_LDB(B0, 0, 0); PG8_SCHED; PG8_LDA(At, 0, 0); PG8_STAGE(PG8_SA(1, 1), a1 + hstep, voffA);
            PG8_WAIT_L(8); PG8_BAR; PG8_WAIT_L(0); PG8_MMA(0, 0, At, B0); PG8_BAR; PG8_SCHED;
            PG8_LDB(B1, 0, 1); PG8_STAGE(PG8_SB(0, 0), b2, voffB);
            PG8_BAR; PG8_WAIT_L(0); PG8_MMA(0, 1, At, B1); PG8_BAR;
            PG8_LDA(At, 0, 1); PG8_STAGE(PG8_SA(0, 0), a2, voffA);
            PG8_BAR; PG8_WAIT_L(0); PG8_MMA(1, 0, At, B0); PG8_BAR; PG8_SCHED;
            PG8_STAGE(PG8_SB(0, 1), b2 + hstep, voffB);
            PG8_WAIT_V(6); PG8_BAR; PG8_MMA(1, 1, At, B1); PG8_BAR;
            PG8_LDB(B0, 1, 0); PG8_SCHED; PG8_LDA(At, 1, 0); PG8_STAGE(PG8_SA(0, 1), a2 + hstep, voffA);
            PG8_WAIT_L(8); PG8_BAR; PG8_WAIT_L(0); PG8_MMA(0, 0, At, B0); PG8_BAR; PG8_SCHED;
            PG8_LDB(B1, 1, 1); PG8_STAGE(PG8_SB(1, 0), b3, voffB);
            PG8_BAR; PG8_WAIT_L(0); PG8_MMA(0, 1, At, B1); PG8_BAR;
            PG8_LDA(At, 1, 1); PG8_STAGE(PG8_SA(1, 0), a3, voffA);
            PG8_BAR; PG8_WAIT_L(0); PG8_MMA(1, 0, At, B0); PG8_BAR; PG8_SCHED;
            PG8_STAGE(PG8_SB(1, 1), b3 + hstep, voffB);
            PG8_WAIT_V(6); PG8_BAR; PG8_MMA(1, 1, At, B1); PG8_BAR;
            }
        }
        if constexpr (ALIGN_EPI) { if (wr == 0) PG8_BAR; }
        if constexpr (!Epi::AFTER_DRAIN) { E(acc, cur, wr, wc, fr, fq); S.done(cur); }
        if (!has_next) break;
#pragma unroll
        for (int a = 0; a < 2; ++a)
#pragma unroll
            for (int b = 0; b < 2; ++b)
#pragma unroll
                for (int m = 0; m < 4; ++m)
#pragma unroll
                    for (int n = 0; n < 2; ++n) acc[a][b][m][n] = (f32x4){0.f, 0.f, 0.f, 0.f};
        cur = nxt; cA = nA; cB = nB; ++ui;
        if constexpr (ALIGN_EPI) { if (wr == 1) PG8_BAR; }
    }
    PG8_WAIT_V(0);
    if constexpr (!ALIGN_EPI) { if (wr == 0) PG8_BAR; }
    PG8_BAR;
    if constexpr (Epi::AFTER_DRAIN) { E.fused(acc, cur, wr, wc, fr, fq, lds, wid, lane); S.done(cur); }
#undef PG8_SA
#undef PG8_SB
#undef PG8_STAGE
#undef PG8_LDA
#undef PG8_LDB
#undef PG8_MMA
#undef PG8_WAIT_V
#undef PG8_WAIT_L
#undef PG8_BAR
#undef PG8_SCHED
}
}

namespace at {
using pg8::bf16_t;
typedef short bf16x8 __attribute__((ext_vector_type(8)));
typedef short s16x4 __attribute__((ext_vector_type(4)));
typedef float f32x16 __attribute__((ext_vector_type(16)));
typedef float f32x4 __attribute__((ext_vector_type(4)));
typedef float f32x2_t __attribute__((ext_vector_type(2)));
typedef __bf16 bf16x2_t __attribute__((ext_vector_type(2)));
typedef unsigned u32x4 __attribute__((ext_vector_type(4)));
typedef unsigned u32x2 __attribute__((ext_vector_type(2)));
#define AT_LAS __attribute__((address_space(3)))
constexpr int PITCH = 6144, KCOL = 1024, VCOL = 2048, TLAST = 2063;
constexpr float THR = 8.0f;
__device__ __forceinline__ unsigned off_b(unsigned row, unsigned ch) { return 256u * row + 16u * (ch ^ (((row & 3u) << 2) | ((row >> 2) & 3u))); }
__device__ __forceinline__ int crow(int r, int hi) { return (r & 3) + 8 * (r >> 2) + 4 * hi; }
__device__ __forceinline__ unsigned cvtpk(float lo, float hi) { f32x2_t v = {lo, hi}; bf16x2_t b = __builtin_convertvector(v, bf16x2_t); return __builtin_bit_cast(unsigned, b); }
__device__ __forceinline__ float swap_max(float m) { auto rr = __builtin_amdgcn_permlane32_swap(__float_as_uint(m), __float_as_uint(m), false, false); return fmaxf(__uint_as_float(rr[0]), __uint_as_float(rr[1])); }
__device__ __forceinline__ float swap_add(float m) { auto rr = __builtin_amdgcn_permlane32_swap(__float_as_uint(m), __float_as_uint(m), false, false); return __uint_as_float(rr[0]) + __uint_as_float(rr[1]); }
__device__ __forceinline__ s16x4 vtr(AT_LAS const unsigned char* p) { return __builtin_bit_cast(s16x4, __builtin_amdgcn_ds_read_tr16_b64_v4i16((AT_LAS s16x4*)p)); }
#define AT_MFMA(a, b, c) __builtin_amdgcn_mfma_f32_32x32x16_bf16((a), (b), (c), 0, 0, 0)

__device__ __forceinline__ void glds16(const void* gsrc, unsigned lds_dst) { unsigned keep;
    asm volatile("s_mov_b32 %0, m0\n\ts_mov_b32 m0, %2\n\ts_nop 0\n\tglobal_load_lds_dwordx4 %1, off\n\ts_mov_b32 m0, %0" : "=&s"(keep) : "v"(gsrc), "s"(lds_dst) : "memory"); }
#define AT_WAIT_BAR(N) asm volatile("s_waitcnt vmcnt(" #N ") lgkmcnt(0)\n\ts_barrier" ::: "memory")
constexpr int SLOT = 32768, NSLOT = 4;

__device__ __forceinline__ void attn_unit(AT_LAS unsigned char* lds, const bf16_t* __restrict__ proj, const bf16_t* __restrict__ metap, bf16_t* __restrict__ cat,
                                          const float* __restrict__ head_g, int b, int h, int qb, float lam) {
    const int tid = threadIdx.x, lane = tid & 63, r32 = lane & 31, hi = lane >> 5;
    const int wid = __builtin_amdgcn_readfirstlane(tid >> 6), map = wid & 1, qblk = wid >> 1;
    const int qrow_g = b * 2048 + 128 * qb + 32 * qblk + r32;
    const int qp_min = 16 + 128 * qb + 32 * qblk, qp = qp_min + r32, qp_max = qp_min + 31;
    const int NT = 2 * qb + 3;
    const float slope2 = __builtin_amdgcn_exp2f(-(float)(h + 1)) * 1.4426950408889634f;
    bf16x8 qf[4];
#pragma unroll
    for (int d0 = 0; d0 < 4; ++d0) qf[d0] = *(const bf16x8*)(proj + (size_t)qrow_g * PITCH + h * 128 + map * 64 + 16 * d0 + 8 * hi);
    const int drow = 4 * wid + (lane >> 4);
    const int dch = (lane & 15) ^ (((drow & 3) << 2) | ((drow >> 2) & 3));
    const unsigned lds0 = (unsigned)(uintptr_t)lds;
    const unsigned ddst = lds0 + (unsigned)wid * 1024u;
#define AT_DMA(j, slot) do { _Pragma("unroll") for (int i_ = 0; i_ < 2; ++i_) { int p_ = 64 * (j) + 32 * i_ + drow; p_ = p_ > TLAST ? TLAST : p_; \
        const bf16_t* rp_ = (p_ < 16 ? metap + (size_t)p_ * PITCH : proj + (size_t)(b * 2048 + p_ - 16) * PITCH) + h * 128 + dch * 8; \
        glds16(rp_ + KCOL, (unsigned)__builtin_amdgcn_readfirstlane(ddst + (slot) * SLOT + i_ * 8192)); \
        glds16(rp_ + VCOL, (unsigned)__builtin_amdgcn_readfirstlane(ddst + (slot) * SLOT + 16384 + i_ * 8192)); } } while (0)
    AT_DMA(0, 0);
    AT_DMA(1, 1);
    unsigned koff[4];
    { const unsigned x = (((unsigned)lane & 3u) << 2) | (((unsigned)lane >> 2) & 3u);
#pragma unroll
      for (int d0 = 0; d0 < 4; ++d0) koff[d0] = 256u * (unsigned)r32 + 16u * (((unsigned)(8 * map + 2 * d0 + hi)) ^ x); }
    unsigned voff[2][4];
    { const unsigned q4 = ((unsigned)lane & 15u) >> 2, p = (unsigned)lane & 3u, blk16 = ((unsigned)lane >> 4) & 1u;
#pragma unroll
      for (int t = 0; t < 2; ++t)
#pragma unroll
          for (int c = 0; c < 4; ++c) voff[t][c] = 256u * (4u * (unsigned)hi + q4) + 16u * ((4u * (unsigned)c + 2u * blk16 + (p >> 1)) ^ ((q4 << 2) | ((2u * (unsigned)t + (unsigned)hi) & 3u))) + 8u * (p & 1u); }
    float cvec[16];
#pragma unroll
    for (int r = 0; r < 16; ++r) cvec[r] = slope2 * (float)((r & 3) + 8 * (r >> 2));
    f32x16 O[4];
#pragma unroll
    for (int c = 0; c < 4; ++c)
#pragma unroll
        for (int r = 0; r < 16; ++r) O[c][r] = 0.f;
    float mref = 0.f, lsum = 0.f;
    const bool late = wid >= 4;
    bf16x8 pf[4];
#pragma unroll
    for (int s = 0; s < 4; ++s) pf[s] = (bf16x8){0, 0, 0, 0, 0, 0, 0, 0};
    AT_WAIT_BAR(4);
#define AT_PV(slotv) do { AT_LAS const unsigned char* vb_ = lds + (slotv) * SLOT + 16384; \
        _Pragma("unroll") for (int c = 0; c < 4; ++c) { AT_LAS const unsigned char* v0_ = vb_ + voff[0][c]; AT_LAS const unsigned char* v1_ = vb_ + voff[1][c]; \
            _Pragma("unroll") for (int s = 0; s < 4; ++s) { \
                const s16x4 lo = vtr(v0_ + ((s >> 1) * 8192 + (s & 1) * 4096)); const s16x4 hh = vtr(v1_ + ((s >> 1) * 8192 + (s & 1) * 4096 + 2048)); \
                const bf16x8 vf = __builtin_shufflevector(lo, hh, 0, 1, 2, 3, 4, 5, 6, 7); O[c] = AT_MFMA(vf, pf[s], O[c]); } } } while (0)
    int slot = 0;
    for (int j = 0; j <= NT; ++j) {
        if (j + 2 < NT) AT_DMA(j + 2, (slot + 2) & 3);
        if (late && j >= 1 && 64 * (j - 1) <= qp_max) AT_PV((slot + 3) & 3);
        if (j < NT && 64 * j <= qp_max) {
            const float tl = slope2 * (float)(64 * j + 4 * hi - qp) - mref;
            f32x16 s0, s1;
#pragma unroll
            for (int r = 0; r < 16; ++r) { s0[r] = tl + cvec[r]; s1[r] = s0[r] + 32.0f * slope2; }
            AT_LAS const unsigned char* kb = lds + slot * SLOT;
#pragma unroll
            for (int d0 = 0; d0 < 4; ++d0) {
                AT_LAS const unsigned char* kp = kb + koff[d0];
                const bf16x8 k0 = *(AT_LAS const bf16x8*)(kp);
                const bf16x8 k1 = *(AT_LAS const bf16x8*)(kp + 8192);
                s0 = AT_MFMA(k0, qf[d0], s0); s1 = AT_MFMA(k1, qf[d0], s1);
            }
            if (64 * j + 63 > qp_min) {
#pragma unroll
                for (int r = 0; r < 16; ++r) { const int kp = 64 * j + crow(r, hi); if (kp > qp) s0[r] = -INFINITY; if (kp + 32 > qp) s1[r] = -INFINITY; }
            }
            float mt = fmaxf(fmaxf(s0[0], s1[0]), fmaxf(s0[1], s1[1]));
#pragma unroll
            for (int r = 2; r < 16; r += 2) mt = fmaxf(mt, fmaxf(fmaxf(s0[r], s1[r]), fmaxf(s0[r + 1], s1[r + 1])));
            mt = swap_max(mt);
            if (j == 0 || __any(mt > THR)) {
                const float dl = j == 0 ? mt : fmaxf(mt, 0.f);
                const float alpha = j == 0 ? 0.f : __builtin_amdgcn_exp2f(-dl);
                lsum *= alpha; mref += dl;
#pragma unroll
                for (int r = 0; r < 16; ++r) { s0[r] -= dl; s1[r] -= dl; }
#pragma unroll
                for (int c = 0; c < 4; ++c)
#pragma unroll
                    for (int r = 0; r < 16; ++r) O[c][r] *= alpha;
            }
            float ps = 0.f;
#pragma unroll
            for (int r = 0; r < 16; ++r) { s0[r] = __builtin_amdgcn_exp2f(s0[r]); s1[r] = __builtin_amdgcn_exp2f(s1[r]); ps += s0[r] + s1[r]; }
            lsum += ps;
#pragma unroll
            for (int s = 0; s < 4; ++s) { u32x4 w;
                if (s < 2) { w.x = cvtpk(s0[8 * s + 0], s0[8 * s + 1]); w.y = cvtpk(s0[8 * s + 2], s0[8 * s + 3]); w.z = cvtpk(s0[8 * s + 4], s0[8 * s + 5]); w.w = cvtpk(s0[8 * s + 6], s0[8 * s + 7]); }
                else { w.x = cvtpk(s1[8 * s - 16], s1[8 * s - 15]); w.y = cvtpk(s1[8 * s - 14], s1[8 * s - 13]); w.z = cvtpk(s1[8 * s - 12], s1[8 * s - 11]); w.w = cvtpk(s1[8 * s - 10], s1[8 * s - 9]); }
                pf[s] = __builtin_bit_cast(bf16x8, w); }
            if (!late) AT_PV(slot);
        }
        if (j + 2 < NT) AT_WAIT_BAR(4); else AT_WAIT_BAR(0);
        slot = (slot + 1) & 3;
    }
#undef AT_PV
    lsum = swap_add(lsum);
    const float inv = 1.0f / lsum;
    AT_LAS f32x4* xch = (AT_LAS f32x4*)(lds + qblk * 16384) + lane;
    if (map == 1) {
#pragma unroll
        for (int c = 0; c < 4; ++c)
#pragma unroll
            for (int g = 0; g < 4; ++g) xch[(c * 4 + g) * 64] = (f32x4){O[c][4 * g] * inv, O[c][4 * g + 1] * inv, O[c][4 * g + 2] * inv, O[c][4 * g + 3] * inv};
    }
    __syncthreads();
    if (map == 0) {
        float ms = 0.f;
#pragma unroll
        for (int c = 0; c < 4; ++c)
#pragma unroll
            for (int g = 0; g < 4; ++g) { const f32x4 o2 = xch[(c * 4 + g) * 64];
#pragma unroll
                for (int e = 0; e < 4; ++e) { const float o = O[c][4 * g + e] * inv - lam * o2[e]; O[c][4 * g + e] = o; ms += o * o; } }
        ms = swap_add(ms);
        const float rn = __builtin_amdgcn_rsqf(ms * (1.0f / 128.0f) + 1e-5f) * 0.8f;
        bf16_t* orow = cat + (size_t)qrow_g * 2048 + h * 128 + 4 * hi;
#pragma unroll
        for (int c = 0; c < 4; ++c)
#pragma unroll
            for (int g = 0; g < 4; ++g) { const f32x4 hg = *(const f32x4*)(head_g + 32 * c + 8 * g + 4 * hi);
                u32x2 w; w.x = cvtpk(O[c][4 * g] * rn * hg[0], O[c][4 * g + 1] * rn * hg[1]); w.y = cvtpk(O[c][4 * g + 2] * rn * hg[2], O[c][4 * g + 3] * rn * hg[3]);
                *(u32x2*)(orow + 32 * c + 8 * g) = w; }
    }
    __syncthreads();
#undef AT_DMA
}
}

namespace cg = cooperative_groups;
#define GAS __attribute__((address_space(1)))
#define LAS __attribute__((address_space(3)))
typedef unsigned short bf16;
typedef unsigned v4u __attribute__((ext_vector_type(4)));
typedef unsigned v2u __attribute__((ext_vector_type(2)));
typedef float f32x4 __attribute__((ext_vector_type(4)));
constexpr int NWAVES = 8;
#ifndef DUP_SYNC
#define DUP_SYNC 0
#endif
#define GSYNC() do { grid.sync(); if (DUP_SYNC) grid.sync(); } while (0)
#define XSYNC() do { xcd_barrier(xbar); if (DUP_SYNC) xcd_barrier(xbar); } while (0)
#ifndef DUP_P3
#define DUP_P3 0
#endif
#ifndef DUP_P5
#define DUP_P5 0
#endif
#ifndef PROBE_SEAM
#define PROBE_SEAM 0
#endif
#define STAMP(k) do { if (PROBE_SEAM == (k) && bx == 0 && tid == 0) { const unsigned long long t_ = __builtin_amdgcn_s_memrealtime(); bar_st[4] = (unsigned)t_; bar_st[5] = (unsigned)(t_ >> 32); } } while (0)
#ifndef DUP_P0
#define DUP_P0 0
#endif
#ifndef DUP_P1
#define DUP_P1 0
#endif
#ifndef DUP_P2
#define DUP_P2 0
#endif
#ifndef DUP_P4
#define DUP_P4 0
#endif
constexpr int BATCH = 8, SEQ = 2048, DM = 2048, M = BATCH * SEQ, NMETA = 16, INW = 6144, DFF = 5632, NGU = 2 * DFF;
constexpr float NORM_EPS = 1e-6f;
constexpr float C2 = 0.125f * 1.4426950408889634f;
constexpr size_t MiB = 1u << 20;
constexpr size_t WS_CTL = 0, CTL_ZERO_BYTES = 1 * MiB;
constexpr size_t WS_BAR = 256 * 1024;
constexpr size_t WS_METAP = 1 * MiB;
constexpr size_t WS_MACC = 384 * 1024;
constexpr size_t WS_WIN = 6 * MiB, WS_WOUT = 30 * MiB, WS_WGU = 38 * MiB, WS_WDN = 82 * MiB;
constexpr size_t WS_A = 104 * MiB;
constexpr size_t WS_PROJ = 168 * MiB;
constexpr size_t WS_CAT = 360 * MiB, WS_END = 424 * MiB;
constexpr int LDS_BYTES = 147456;
constexpr int MP_KC = 8, MP_COLS = 5120;

__device__ __forceinline__ float wave_sum(float v) {
#pragma unroll
    for (int o = 1; o < 64; o <<= 1) v += __shfl_xor(v, o);
    return v;
}
__device__ __forceinline__ float bf2f(unsigned short h) { return __uint_as_float(((unsigned)h) << 16); }
#define LDS_WAIT() asm volatile("s_waitcnt lgkmcnt(0)" ::: "memory")

__device__ __forceinline__ void tr_item(const float* __restrict__ W, int N, int k0, int n0, const float* __restrict__ kscale, bf16* __restrict__ out, int out_ld, int out_row0, LAS float* scr, int lane,
                                        float* __restrict__ macc_, const float* __restrict__ metaw, const float* __restrict__ mg) {
    float v[64];
#pragma unroll
    for (int i = 0; i < 64; ++i) v[i] = __builtin_nontemporal_load(W + (size_t)(k0 + i) * N + n0 + lane);
#pragma unroll
    for (int i = 0; i < 64; ++i) { float t = v[i]; if (kscale) t *= kscale[k0 + i]; scr[i * 65 + lane] = t; }
    LDS_WAIT(); asm volatile("" ::: "memory");
    const int c = lane & 7;
#pragma unroll
    for (int j = 0; j < 8; ++j) { const int n = (lane >> 3) + 8 * j; const LAS float* s = scr + (8 * c) * 65 + n;
        v4u o; o.x = pg8::cvt_pk_bf16(s[0 * 65], s[1 * 65]); o.y = pg8::cvt_pk_bf16(s[2 * 65], s[3 * 65]); o.z = pg8::cvt_pk_bf16(s[4 * 65], s[5 * 65]); o.w = pg8::cvt_pk_bf16(s[6 * 65], s[7 * 65]);
        *(v4u*)(out + (size_t)(out_row0 + n) * out_ld + k0 + 8 * c) = o; }
    if (macc_) {
        float acc[16];
#pragma unroll
        for (int r = 0; r < 16; ++r) acc[r] = 0.f;
#pragma unroll 8
        for (int i = 0; i < 64; ++i) { const float w = scr[i * 65 + lane] * mg[k0 + i];
#pragma unroll
            for (int r = 0; r < 16; ++r) acc[r] = fmaf(metaw[r * 2048 + k0 + i], w, acc[r]); }
#pragma unroll
        for (int r = 0; r < 16; ++r) atomicAdd(macc_ + r * 5120 + (n0 - 1024) + lane, acc[r]);
    }
    LDS_WAIT(); asm volatile("" ::: "memory");
}

#define XB_TMO      128
#define XB_XCNT(j)  (256  + 64 * (j))
#define XB_XSUB(j)  (1280 + 64 * (j))
#define XB_XGEN(j)  (2304 + 64 * (j))
#define XB_TOP      3328
#define XB_TOPGEN   3392
#define XCD_BAR_WORDS 3456
#define XB_SPIN_CAP (1u << 18)

__device__ __forceinline__ unsigned xb_ld(unsigned* p)              { return __hip_atomic_load(p, __ATOMIC_RELAXED, __HIP_MEMORY_SCOPE_AGENT); }
__device__ __forceinline__ unsigned xb_add(unsigned* p, unsigned v) { return __hip_atomic_fetch_add(p, v, __ATOMIC_RELAXED, __HIP_MEMORY_SCOPE_AGENT); }
__device__ __forceinline__ unsigned xb_xcc_id() { return (unsigned)__builtin_amdgcn_s_getreg((3 << 11) | 20) & 0xFu; }
#define XB_SPIN(cond, bar) do { unsigned _sp = 0; while (cond) { __builtin_amdgcn_s_sleep(1); \
    if ((++_sp & 255u) == 0u) { if (xb_ld(&(bar)[XB_TMO])) break; if (_sp > XB_SPIN_CAP) { atomicAdd(&(bar)[XB_TMO], 1u); break; } } } } while (0)

struct XcdBarrier {
    unsigned* bar; unsigned x;
    volatile LAS unsigned* st;
};

__device__ __forceinline__ XcdBarrier xcd_barrier_post(unsigned* bar, volatile LAS unsigned* st) {
    XcdBarrier b; b.bar = bar; b.x = xb_xcc_id(); b.st = st;
    if (threadIdx.x == 0) (void)xb_add(&bar[XB_XCNT(b.x)], 1u);
    return b;
}
__device__ __forceinline__ void xcd_barrier_complete(unsigned* bar, unsigned x, unsigned& nloc, unsigned& nx) {
    const unsigned G = gridDim.x * gridDim.y * gridDim.z;
    unsigned sum, cnt, mine, sp = 0u;
    for (;;) {
        sum = 0u; cnt = 0u; mine = 0u;
#pragma unroll
        for (unsigned j = 0; j < 16; ++j) { const unsigned c = xb_ld(&bar[XB_XCNT(j)]); sum += c; cnt += (c > 0u) ? 1u : 0u; mine = (j == x) ? c : mine; }
        if (sum == G) break;
        __builtin_amdgcn_s_sleep(1);
        if ((++sp & 255u) == 0u) { if (xb_ld(&bar[XB_TMO])) break; if (sp > XB_SPIN_CAP) { atomicAdd(&bar[XB_TMO], 1u); break; } }
    }
    nloc = mine > 0u ? mine : 1u; nx = cnt > 0u ? cnt : 1u;
}

__device__ __forceinline__ void xcd_barrier(const XcdBarrier& b) {
    asm volatile("s_waitcnt vmcnt(0)" ::: "memory");
    __syncthreads();
    if (threadIdx.x == 0) {
        unsigned* bar = b.bar;
        __builtin_amdgcn_s_waitcnt(0);
        unsigned nloc = b.st[0], nx = b.st[1];
        if (nloc == 0u) { xcd_barrier_complete(bar, b.x, nloc, nx); b.st[0] = nloc; b.st[1] = nx; }
        const unsigned old = xb_add(&bar[XB_XSUB(b.x)], 1u);
        const unsigned gen = old / nloc;
        if (old + 1u == (gen + 1u) * nloc) {
            __builtin_amdgcn_fence(__ATOMIC_RELEASE, "agent");
            asm volatile("s_waitcnt vmcnt(0)" ::: "memory");
            const unsigned og = xb_add(&bar[XB_TOP], 1u);
            const unsigned tg = og / nx;
            if (og + 1u == (tg + 1u) * nx) xb_add(&bar[XB_TOPGEN], 1u);
            else XB_SPIN(xb_ld(&bar[XB_TOPGEN]) == tg, bar);
            __builtin_amdgcn_fence(__ATOMIC_ACQUIRE, "agent");
            xb_add(&bar[XB_XGEN(b.x)], 1u);
            asm volatile("s_waitcnt vmcnt(0)" ::: "memory");
        } else {
            XB_SPIN(xb_ld(&bar[XB_XGEN(b.x)]) == gen, bar);
            __builtin_amdgcn_fence(__ATOMIC_ACQUIRE, "agent");
            asm volatile("s_waitcnt vmcnt(0)" ::: "memory");
        }
    }
    __syncthreads();
}

struct Args { const float* in[16]; float* out; unsigned char* ws; };

__global__ void __launch_bounds__(NWAVES * 64, 2) hymba_fwd(Args args) {
    extern __shared__ __attribute__((aligned(16))) unsigned char lds_raw[];
    cg::grid_group grid = cg::this_grid();
    LAS unsigned char* lds = (LAS unsigned char*)lds_raw;
    const int tid = threadIdx.x, lane = tid & 63, wave = __builtin_amdgcn_readfirstlane(tid >> 6);
    const int G = gridDim.x, bx = blockIdx.x;
    const int vcu = (G % 8 == 0) ? (bx % 8) * (G / 8) + bx / 8 : bx;
    const int gw = __builtin_amdgcn_readfirstlane(vcu * NWAVES + wave), NGW = G * NWAVES;
    volatile LAS unsigned* bar_st = (volatile LAS unsigned*)(lds + 139264);
    if (tid < 2) bar_st[tid] = 0u;
    if (PROBE_SEAM && bx == 0 && tid == 0) { const unsigned long long t_ = __builtin_amdgcn_s_memrealtime(); bar_st[2] = (unsigned)t_; bar_st[3] = (unsigned)(t_ >> 32); }
    __syncthreads();
    const XcdBarrier xbar = xcd_barrier_post((unsigned*)(args.ws + WS_BAR), bar_st);
#define WSP (args.ws)
#define XIN (args.in[0])
#define meta (args.in[1])
#define g1 (args.in[2])
#define w_in (args.in[3])
#define head_g (args.in[8])
#define conv_w (args.in[9])
#define w_out (args.in[10])
#define g2 (args.in[11])
#define w_gate (args.in[12])
#define w_up (args.in[13])
#define w_down (args.in[14])
#define gf (args.in[15])
#define OUTP (args.out)
#define ssq1 ((float*)(WSP + WS_CTL))
#define ssq2 (((float*)(WSP + WS_CTL)) + M)
#define xsc (((float*)(WSP + WS_CTL)) + 3 * M)
#define metap ((bf16*)(WSP + WS_METAP))
#define macc ((float*)(WSP + WS_MACC))
#define Win_t ((bf16*)(WSP + WS_WIN))
#define Wout_t ((bf16*)(WSP + WS_WOUT))
#define Wgu_t ((bf16*)(WSP + WS_WGU))
#define Wdn_t ((bf16*)(WSP + WS_WDN))
#define Abuf ((bf16*)(WSP + WS_A))
#define proj ((bf16*)(WSP + WS_PROJ))
#define act ((bf16*)(WSP + WS_PROJ))
#define cat ((bf16*)(WSP + WS_CAT))
    {
        LAS float* scr = (LAS float*)(lds + wave * 16640);
        constexpr int I_IN = 32 * 96, I_OUT = 32 * 32, I_G = 32 * 88, I_D = 88 * 32, NITEMS = I_IN + I_OUT + 2 * I_G + I_D;
        for (int it = gw; it < NITEMS * (1 + DUP_P0); it += NGW) {
            int r = it % NITEMS;
            if (r < I_IN) { const int n0 = 64 * (r % 96); tr_item(w_in, INW, 64 * (r / 96), n0, nullptr, Win_t, DM, n0, scr, lane, n0 >= 1024 ? macc : nullptr, meta, g1); continue; } r -= I_IN;
            if (r < I_OUT) { tr_item(w_out, DM, 64 * (r / 32), 64 * (r % 32), nullptr, Wout_t, DM, 64 * (r % 32), scr, lane, nullptr, nullptr, nullptr); continue; } r -= I_OUT;
            if (r < I_G) { const int n0 = 64 * (r % 88); tr_item(w_gate, DFF, 64 * (r / 88), n0, g2, Wgu_t, DM, 256 * (n0 / 128) + (n0 % 128), scr, lane, nullptr, nullptr, nullptr); continue; } r -= I_G;
            if (r < I_G) { const int n0 = 64 * (r % 88); tr_item(w_up, DFF, 64 * (r / 88), n0, g2, Wgu_t, DM, 256 * (n0 / 128) + 128 + (n0 % 128), scr, lane, nullptr, nullptr, nullptr); continue; } r -= I_G;
            tr_item(w_down, DM, 64 * (r / 32), 64 * (r % 32), nullptr, Wdn_t, DFF, 64 * (r % 32), scr, lane, nullptr, nullptr, nullptr);
        }
        for (int m_ = gw; m_ < (M / 2) * (1 + DUP_P0); m_ += NGW) { const int m = (m_ % (M / 2)) * 2;
            const f32x4* xr = (const f32x4*)(XIN + (size_t)m * DM) + lane; f32x4 v[2][8]; float s[2] = {0.f, 0.f};
#pragma unroll
            for (int q = 0; q < 2; ++q)
#pragma unroll
                for (int j = 0; j < 8; ++j) v[q][j] = __builtin_nontemporal_load(xr + q * (DM / 4) + 64 * j);
#pragma unroll
            for (int q = 0; q < 2; ++q)
#pragma unroll
                for (int j = 0; j < 8; ++j) s[q] += (v[q][j].x * v[q][j].x + v[q][j].y * v[q][j].y) + (v[q][j].z * v[q][j].z + v[q][j].w * v[q][j].w);
#pragma unroll
            for (int q = 0; q < 2; ++q) {
                const float ms_ = wave_sum(s[q]) * (1.0f / DM) + NORM_EPS; const float rs = __builtin_amdgcn_rsqf(ms_);
                if (lane == 0) xsc[m + q] = __builtin_sqrtf(ms_);
                v2u* o8 = (v2u*)(Abuf + (size_t)(m + q) * DM) + lane;
#pragma unroll
                for (int j = 0; j < 8; ++j) { const f32x4 g = ((const f32x4*)g1)[64 * j + lane]; v2u w; w.x = pg8::cvt_pk_bf16(v[q][j].x * rs * g.x, v[q][j].y * rs * g.y); w.y = pg8::cvt_pk_bf16(v[q][j].z * rs * g.z, v[q][j].w * rs * g.w); o8[64 * j] = w; }
            }
        }
    }
    if (args.out == nullptr) grid.sync();
    XSYNC();
    STAMP(1);

    if (bx < 16) {
        const int r = bx; float s = 0.f;
        for (int k = lane; k < DM; k += 64) { const float v = meta[r * DM + k]; s += v * v; }
        const float rs = __builtin_amdgcn_rsqf(wave_sum(s) * (1.0f / DM) + NORM_EPS);
        for (int c = tid; c < MP_COLS; c += NWAVES * 64) { const float a = macc[(size_t)r * MP_COLS + c];
            metap[(size_t)r * INW + 1024 + c] = (bf16)(pg8::cvt_pk_bf16(a * rs, 0.f) & 0xffffu); }
    }
    {
        pg8::Gemm g{Abuf, Win_t, M, INW, DM}; pg8::StaticOrder S; S.init(M, INW, G, bx); S.reps = 1 + DUP_P1;
        pg8::EpiProj E{proj, C2};
        pg8::gemm_phase<pg8::EpiProj, pg8::StaticOrder, true, true>(lds, g, S, E);
    }
    XSYNC();
    STAMP(2);

    {
        float lam;
        { const float a = args.in[4][lane] * args.in[5][lane], c = args.in[6][lane] * args.in[7][lane];
          lam = __expf(wave_sum(a)) - __expf(wave_sum(c)) + 0.2f; }
        for (int pi_ = vcu; pi_ < 512 * (1 + DUP_P2); pi_ += G) { const int pi = pi_ & 511;
            const int bh = pi >> 3, s = pi & 7;
            at::attn_unit(lds, proj, metap, cat, head_g, bh >> 3, bh & 7, 15 - s, lam);
            at::attn_unit(lds, proj, metap, cat, head_g, bh >> 3, bh & 7, s, lam);
        }
        for (int idx_ = vcu * (NWAVES * 64) + tid; idx_ < (M / 2) * 128 * (1 + DUP_P2); idx_ += G * NWAVES * 64) { const int idx = idx_ % ((M / 2) * 128);
            const int row = (idx >> 7) * 2, c8 = (idx & 127) * 8, sq = row & (SEQ - 1);
            const bf16* r0 = proj + (size_t)row * INW;
            v4u cv[4], hv[4], bgv[2];
#pragma unroll
            for (int t = 0; t < 4; ++t) { const int sp = sq + t - 2; const bf16* rp = sp >= 0 ? r0 + (ptrdiff_t)(t - 2) * INW : metap + (size_t)(16 + sp) * INW;
                cv[t] = *(const v4u*)(rp + 4096 + c8); hv[t] = *(const v4u*)(rp + 5120 + c8); }
#pragma unroll
            for (int t = 0; t < 2; ++t) bgv[t] = *(const v4u*)(r0 + (size_t)t * INW + 3072 + c8);
            v4u o[2];
#pragma unroll
            for (int w = 0; w < 4; ++w) { float y[2][2];
#pragma unroll
                for (int hh = 0; hh < 2; ++hh) { const int e = 2 * w + hh, sh = hh * 16; float u[4];
#pragma unroll
                    for (int t = 0; t < 4; ++t) u[t] = __uint_as_float((cv[t][w] >> sh) << 16) * __uint_as_float((hv[t][w] >> sh) << 16);
                    const float w0 = conv_w[c8 + e], w1 = conv_w[1024 + c8 + e], w2 = conv_w[2048 + c8 + e];
#pragma unroll
                    for (int t = 0; t < 2; ++t) y[t][hh] = __uint_as_float((bgv[t][w] >> sh) << 16) * (w0 * u[t] + w1 * u[t + 1] + w2 * u[t + 2]); }
                o[0][w] = pg8::cvt_pk_bf16(y[0][0], y[0][1]); o[1][w] = pg8::cvt_pk_bf16(y[1][0], y[1][1]); }
            *(v4u*)(cat + (size_t)row * DM + 1024 + c8) = o[0]; *(v4u*)(cat + (size_t)(row + 1) * DM + 1024 + c8) = o[1];
        }
    }
    XSYNC();
    STAMP(3);

    {
        pg8::Gemm g{cat, Wout_t, M, DM, DM}; pg8::StaticOrder S; S.init(M, DM, G, bx); S.reps = 1 + DUP_P3;
        pg8::EpiRes1 E{xsc, g1, Abuf, ssq1, 2 * M};
        pg8::gemm_phase<pg8::EpiRes1, pg8::StaticOrder, true, true>(lds, g, S, E);
    }
    XSYNC();
    STAMP(4);

    {
        pg8::Gemm g{Abuf, Wgu_t, M, NGU, DM}; pg8::StaticOrder S; S.init(M, NGU, G, bx); S.reps = 1 + DUP_P4;
        pg8::EpiGU E{act, ssq1};
        pg8::gemm_phase<pg8::EpiGU, pg8::StaticOrder, true, true>(lds, g, S, E);
    }
    XSYNC();
    STAMP(5);

    {
        pg8::Gemm g{act, Wdn_t, M, DM, DFF}; pg8::StaticOrder S; S.init(M, DM, G, bx); S.reps = 1 + DUP_P5;
        pg8::EpiRes2 E{Abuf, cat, ssq2, M};
        pg8::gemm_phase<pg8::EpiRes2, pg8::StaticOrder, true, true>(lds, g, S, E);
    }
    XSYNC();
    STAMP(6);

    for (int m = gw; m < M; m += NGW) {
        const float rs = __builtin_amdgcn_rsqf(ssq2[m] * (1.0f / DM) + NORM_EPS);
        const v4u* hr = (const v4u*)(cat + (size_t)m * DM) + lane;
        f32x4* o = (f32x4*)(OUTP + (size_t)m * DM);
        v4u hv[4];
#pragma unroll
        for (int j = 0; j < 4; ++j) hv[j] = hr[64 * j];
#pragma unroll
        for (int j = 0; j < 4; ++j) { const int c8 = (64 * j + lane) * 2; const f32x4 ga = ((const f32x4*)gf)[c8], gb = ((const f32x4*)gf)[c8 + 1];
            f32x4 va, vb; va.x = pg8::bflo(hv[j].x) * rs * ga.x; va.y = pg8::bfhi(hv[j].x) * rs * ga.y; va.z = pg8::bflo(hv[j].y) * rs * ga.z; va.w = pg8::bfhi(hv[j].y) * rs * ga.w;
            vb.x = pg8::bflo(hv[j].z) * rs * gb.x; vb.y = pg8::bfhi(hv[j].z) * rs * gb.y; vb.z = pg8::bflo(hv[j].w) * rs * gb.z; vb.w = pg8::bfhi(hv[j].w) * rs * gb.w;
            __builtin_nontemporal_store(va, o + c8); __builtin_nontemporal_store(vb, o + c8 + 1); }
    }
    if (PROBE_SEAM && bx == 0 && tid == 0) {
        const unsigned long long t0_ = ((unsigned long long)bar_st[3] << 32) | bar_st[2], t1_ = ((unsigned long long)bar_st[5] << 32) | bar_st[4];
        const unsigned long long wait_ = 8ull * (t1_ - t0_), s0_ = __builtin_amdgcn_s_memrealtime();
        while (__builtin_amdgcn_s_memrealtime() - s0_ < wait_) __builtin_amdgcn_s_sleep(32);
    }
}

#undef WSP
#undef XIN
#undef meta
#undef g1
#undef w_in
#undef head_g
#undef conv_w
#undef w_out
#undef g2
#undef w_gate
#undef w_up
#undef w_down
#undef gf
#undef OUTP
#undef ssq1
#undef ssq2
#undef xsc
#undef metap
#undef macc
#undef Win_t
#undef Wout_t
#undef Wgu_t
#undef Wdn_t
#undef Abuf
#undef proj
#undef act
#undef cat

extern "C" void kernel_launch(void* const* d_in, const int* in_sizes, int n_in, void* d_out, int out_size, void* d_ws, size_t ws_size, hipStream_t stream) {
    static int grid_blocks = 0;
    if (grid_blocks == 0) {
        if (n_in != 16 || in_sizes[0] != M * DM || out_size != M * DM || ws_size < WS_END) { fprintf(stderr, "kernel_launch: unexpected shapes (n_in %d, in0 %d, out %d, ws %zu)\n", n_in, n_in > 0 ? in_sizes[0] : -1, out_size, ws_size); grid_blocks = -1; return; }
        int dev = 0, cus = 0, per_cu = 0;
        (void)hipGetDevice(&dev); (void)hipDeviceGetAttribute(&cus, hipDeviceAttributeMultiprocessorCount, dev);
        if (hipFuncSetAttribute((const void*)hymba_fwd, hipFuncAttributeMaxDynamicSharedMemorySize, LDS_BYTES) != hipSuccess) fprintf(stderr, "kernel_launch: hipFuncSetAttribute failed\n");
        if (hipOccupancyMaxActiveBlocksPerMultiprocessor(&per_cu, (const void*)hymba_fwd, NWAVES * 64, LDS_BYTES) != hipSuccess || per_cu < 1) { fprintf(stderr, "kernel_launch: occupancy query gave %d\n", per_cu); per_cu = 1; }
        (void)hipGetLastError();
        grid_blocks = cus * per_cu;
    }
    if (grid_blocks < 0) return;
    (void)hipMemsetAsync((char*)d_ws + WS_CTL, 0, CTL_ZERO_BYTES, stream);
    Args a{};
    for (int i = 0; i < 16; ++i) a.in[i] = (const float*)d_in[i];
    a.out = (float*)d_out; a.ws = (unsigned char*)d_ws;
    void* kargs[] = {&a};
    hipError_t e = hipLaunchCooperativeKernel((const void*)hymba_fwd, dim3(grid_blocks), dim3(NWAVES * 64), kargs, LDS_BYTES, stream);
    if (e != hipSuccess) fprintf(stderr, "cooperative launch failed: %s (grid %d)\n", hipGetErrorString(e), grid_blocks);
}
```
